# Optimizing an MI355X kernel written in HIP

```python
import math
import jax, jax.numpy as jnp
from jax import lax
import numpy as np

D_MODEL = 1024
BATCH = 4
SEQ = 4096
DEPTH = 2

N_A = DEPTH // 2
N_B = DEPTH - N_A
CONV_W = 3
N_HEADS = 8
HEAD_DIM = D_MODEL // N_HEADS
BLOCK = 256
TOPK = 3
Q_CHUNK = 32
ROT_DIM = HEAD_DIM // 4
ROPE_THETA = 500000.0
MEM_LEN = 256
MEM_HEADS = 4
MEM_HEAD_DIM = D_MODEL // MEM_HEADS
D_FF = ((8 * D_MODEL + 3 * 256 - 1) // (3 * 256)) * 256
EPS = 1e-6

kernel_name = "yoco_shortconv_moba_hybrid"


def rms_norm(x, g):
    x32 = x.astype(jnp.float32)
    y = x32 * lax.rsqrt(jnp.mean(x32 * x32, axis=-1, keepdims=True) + EPS)
    return (y * g.astype(jnp.float32)).astype(x.dtype)


def rope_cos_sin(positions):
    inv_freq = ROPE_THETA ** (-jnp.arange(0, ROT_DIM, 2, dtype=jnp.float32) / ROT_DIM)
    ang = positions.astype(jnp.float32)[..., None] * inv_freq
    return jnp.cos(ang)[:, :, None, :], jnp.sin(ang)[:, :, None, :]


def apply_partial_rope(x, cos, sin):
    xr = x[..., :ROT_DIM].astype(jnp.float32)
    x1, x2 = xr[..., : ROT_DIM // 2], xr[..., ROT_DIM // 2:]
    rot = jnp.concatenate([x1 * cos - x2 * sin, x2 * cos + x1 * sin], axis=-1)
    return jnp.concatenate([rot.astype(x.dtype), x[..., ROT_DIM:]], axis=-1)


def short_conv_mixer(h, w_in, w_conv, w_out):
    b_gate, c_gate, u = jnp.split(h @ w_in, 3, axis=-1)
    z = c_gate * u
    conv = lax.conv_general_dilated(
        z, w_conv[:, None, :].astype(z.dtype), window_strides=(1,),
        padding=[(CONV_W - 1, 0)], dimension_numbers=("NWC", "WIO", "NWC"),
        feature_group_count=D_MODEL)
    return (b_gate * conv) @ w_out


def mem_cross_attention(h, mem_n, w_q, w_kv, w_o):
    bsz, seq, _ = h.shape
    q = (h @ w_q).reshape(bsz, seq, MEM_HEADS, MEM_HEAD_DIM)
    k, v = jnp.split(mem_n @ w_kv, 2, axis=-1)
    k = k.reshape(bsz, -1, MEM_HEADS, MEM_HEAD_DIM)
    v = v.reshape(bsz, -1, MEM_HEADS, MEM_HEAD_DIM)
    s = jnp.einsum("bshd,bmhd->bhsm", q, k).astype(jnp.float32) * (MEM_HEAD_DIM ** -0.5)
    p = jax.nn.softmax(s, axis=-1).astype(v.dtype)
    o = jnp.einsum("bhsm,bmhd->bshd", p, v).reshape(bsz, seq, D_MODEL)
    return o @ w_o


def swiglu(h, w_gu, w_down):
    g, u = jnp.split(h @ w_gu, 2, axis=-1)
    return (jax.nn.silu(g) * u) @ w_down


def shared_kv(x, kv_norm, w_kv, cos, sin):
    bsz, seq, _ = x.shape
    n_blocks = -(-seq // BLOCK)
    pad = n_blocks * BLOCK - seq
    k, v = jnp.split(rms_norm(x, kv_norm) @ w_kv, 2, axis=-1)
    k = apply_partial_rope(k.reshape(bsz, seq, N_HEADS, HEAD_DIM), cos, sin)
    v = v.reshape(bsz, seq, N_HEADS, HEAD_DIM)
    k = jnp.pad(k, ((0, 0), (0, pad), (0, 0), (0, 0)))
    v = jnp.pad(v, ((0, 0), (0, pad), (0, 0), (0, 0)))
    k_blk = k.transpose(0, 2, 1, 3).reshape(bsz, N_HEADS, n_blocks, BLOCK, HEAD_DIM)
    v_blk = v.transpose(0, 2, 1, 3).reshape(bsz, N_HEADS, n_blocks, BLOCK, HEAD_DIM)
    k_mean = jnp.mean(k_blk.astype(jnp.float32), axis=3)
    return k_blk, v_blk, k_mean


def moba_attention(h, w_q, w_o, cos, sin, k_blk, v_blk, k_mean):
    bsz, seq, _ = h.shape
    n_blocks = k_blk.shape[2]
    k_sel = min(TOPK, n_blocks)
    n_chunks = seq // Q_CHUNK
    scale = HEAD_DIM ** -0.5
    q = apply_partial_rope((h @ w_q).reshape(bsz, seq, N_HEADS, HEAD_DIM), cos, sin)
    q_chunks = q.transpose(0, 2, 1, 3).reshape(bsz, N_HEADS, n_chunks, Q_CHUNK, HEAD_DIM)
    q_chunks = q_chunks.transpose(2, 0, 1, 3, 4)
    bi = jnp.arange(bsz)[:, None, None, None]
    hi = jnp.arange(N_HEADS)[None, :, None, None]

    def chunk_fn(args):
        c, q_c = args
        qpos = c * Q_CHUNK + jnp.arange(Q_CHUNK)
        qb = (c * Q_CHUNK) // BLOCK
        gate = jnp.einsum("bhqd,bhnd->bhqn", q_c.astype(jnp.float32), k_mean)
        past = jnp.arange(n_blocks) < qb
        gate = jnp.where(past[None, None, None, :], gate, -jnp.inf)
        _, idx = lax.top_k(gate, k_sel)
        valid = idx < qb
        kg = k_blk[bi, hi, idx]
        vg = v_blk[bi, hi, idx]
        s_sel = jnp.einsum("bhqd,bhqrkd->bhqrk", q_c, kg).astype(jnp.float32) * scale
        s_sel = jnp.where(valid[..., None], s_sel, -jnp.inf)
        s_sel = s_sel.reshape(bsz, N_HEADS, Q_CHUNK, k_sel * BLOCK)
        k_own = lax.dynamic_index_in_dim(k_blk, qb, axis=2, keepdims=False)
        v_own = lax.dynamic_index_in_dim(v_blk, qb, axis=2, keepdims=False)
        s_own = jnp.einsum("bhqd,bhkd->bhqk", q_c, k_own).astype(jnp.float32) * scale
        kpos = qb * BLOCK + jnp.arange(BLOCK)
        s_own = jnp.where((kpos[None, :] <= qpos[:, None])[None, None], s_own, -jnp.inf)
        p = jax.nn.softmax(jnp.concatenate([s_sel, s_own], axis=-1), axis=-1)
        p_sel = p[..., : k_sel * BLOCK].reshape(bsz, N_HEADS, Q_CHUNK, k_sel, BLOCK)
        p_own = p[..., k_sel * BLOCK:]
        o = jnp.einsum("bhqrk,bhqrkd->bhqd", p_sel.astype(vg.dtype), vg)
        o = o + jnp.einsum("bhqk,bhkd->bhqd", p_own.astype(v_own.dtype), v_own)
        return o

    out = lax.map(chunk_fn, (jnp.arange(n_chunks, dtype=jnp.int32), q_chunks))
    out = out.transpose(1, 0, 3, 2, 4).reshape(bsz, seq, D_MODEL)
    return out @ w_o


def setup_inputs(seed: int = 0) -> dict:
    key = jax.random.key(seed)
    ks = jax.random.split(key, 24)
    f32 = jnp.float32

    def w(k, shape, fan_in):
        return jax.random.normal(k, shape, f32) * (fan_in ** -0.5)

    def gain(k, shape):
        return 1.0 + 0.02 * jax.random.normal(k, shape, f32)

    x = jax.random.normal(ks[0], (BATCH, SEQ, D_MODEL), f32)
    mem = jax.random.normal(ks[1], (BATCH, MEM_LEN, D_MODEL), f32)
    offset = jax.random.randint(ks[2], (BATCH, 1), 0, 8192, dtype=jnp.int32)
    positions = offset + jnp.arange(SEQ, dtype=jnp.int32)[None, :]
    return {
        "x": x,
        "mem": mem,
        "positions": positions,
        "norm_mix": gain(ks[3], (DEPTH, D_MODEL)),
        "norm_mem": gain(ks[4], (DEPTH, D_MODEL)),
        "norm_memkv": gain(ks[5], (DEPTH, D_MODEL)),
        "norm_ffn": gain(ks[6], (DEPTH, D_MODEL)),
        "norm_final": gain(ks[7], (D_MODEL,)),
        "conv_w_in": w(ks[8], (N_A, D_MODEL, 3 * D_MODEL), D_MODEL),
        "conv_w": w(ks[9], (N_A, CONV_W, D_MODEL), CONV_W),
        "conv_w_out": w(ks[10], (N_A, D_MODEL, D_MODEL), D_MODEL),
        "kv_norm": gain(ks[11], (D_MODEL,)),
        "w_kv": w(ks[12], (D_MODEL, 2 * D_MODEL), D_MODEL),
        "moba_w_q": w(ks[13], (N_B, D_MODEL, D_MODEL), D_MODEL),
        "moba_w_o": w(ks[14], (N_B, D_MODEL, D_MODEL), D_MODEL),
        "mem_w_q": w(ks[15], (DEPTH, D_MODEL, D_MODEL), D_MODEL),
        "mem_w_kv": w(ks[16], (DEPTH, D_MODEL, 2 * D_MODEL), D_MODEL),
        "mem_w_o": w(ks[17], (DEPTH, D_MODEL, D_MODEL), D_MODEL),
        "ffn_w_gu": w(ks[18], (DEPTH, D_MODEL, 2 * D_FF), D_MODEL),
        "ffn_w_down": w(ks[19], (DEPTH, D_FF, D_MODEL), D_FF),
    }


def reference(x, mem, positions, norm_mix, norm_mem, norm_memkv, norm_ffn, norm_final,
              conv_w_in, conv_w, conv_w_out, kv_norm, w_kv, moba_w_q, moba_w_o,
              mem_w_q, mem_w_kv, mem_w_o, ffn_w_gu, ffn_w_down):
    cos, sin = rope_cos_sin(positions)
    k_blk = v_blk = k_mean = None
    for l in range(DEPTH):
        h = rms_norm(x, norm_mix[l])
        if l < N_A:
            x = x + short_conv_mixer(h, conv_w_in[l], conv_w[l], conv_w_out[l])
        else:
            j = l - N_A
            x = x + moba_attention(h, moba_w_q[j], moba_w_o[j], cos, sin, k_blk, v_blk, k_mean)
        x = x + mem_cross_attention(rms_norm(x, norm_mem[l]), rms_norm(mem, norm_memkv[l]),
                                    mem_w_q[l], mem_w_kv[l], mem_w_o[l])
        x = x + swiglu(rms_norm(x, norm_ffn[l]), ffn_w_gu[l], ffn_w_down[l])
        if l == N_A - 1:
            k_blk, v_blk, k_mean = shared_kv(x, kv_norm, w_kv, cos, sin)
    return rms_norm(x, norm_final)
```

```cpp
#include <hip/hip_runtime.h>
#include <hip/hip_cooperative_groups.h>
#include <cstdio>
#include <cstdint>
namespace cg = cooperative_groups;
namespace pg8 {
#define PG8_LAS __attribute__((address_space(3)))
typedef unsigned short bf16_t;
typedef short bf16x8 __attribute__((ext_vector_type(8)));
typedef float f32x4 __attribute__((ext_vector_type(4)));
typedef unsigned u32x4 __attribute__((ext_vector_type(4)));
constexpr int BM = 256, BK = 64, HALF = 128, HTB = HALF * BK * 2  , STAGE_BYTES = 8 * HTB, NXCD = 8, WGM = 2;

__host__ __device__ __forceinline__ int lds_byte(int r, int c) { const int st = (r >> 4) * 2 + (c >> 5), rr = r & 15, cc = c & 31, ob = rr * 64 + cc * 2; return st * 1024 + (ob ^ (((ob >> 9) & 1) << 5)); }
__host__ __device__ __forceinline__ void stage_rc(int b, int& R, int& C) { const int st = b / 1024, sb = b % 1024, swz = sb ^ (((sb >> 9) & 1) << 5); R = (st >> 1) * 16 + swz / 64; C = (st & 1) * 32 + (swz % 64) / 2; }
__host__ __device__ __forceinline__ int perm32(int rho) { const int n = rho >> 4, i = rho & 15; return 8 * (i >> 2) + 4 * n + (i & 3); }

struct Unit { int pm, pn, roff, half; };
struct Gemm { const bf16_t* A; const bf16_t* Bt; int M, N, K; };

struct StaticOrder {
    int nM, nN, nwg, G, c, hs;
    __host__ __device__ void init(int M, int N, int G_, int c_) { nM = M / BM; nN = N / BM; nwg = nM * nN; G = G_; c = c_; hs = (2 * (nwg % G) == G) ? 1 : 0; }
    __host__ __device__ bool next(int i, Unit& u) const {
        long L = (long)i * G + c; u.roff = 0; u.half = 0;
        if (hs) { const int nfr = nwg / G; if (i > nfr) return false; if (i == nfr) { L = (long)nfr * G + (c >> 1); u.roff = c & 1; u.half = 1; } }
        if (L >= nwg) return false;
        int wgid = (int)L; { const int q = nwg / NXCD, r = nwg % NXCD, xcd = wgid % NXCD, off = wgid / NXCD; wgid = (xcd < r ? xcd * (q + 1) : r * (q + 1) + (xcd - r) * q) + off; }
        const int nig = WGM * nN, gid = wgid / nig, fm = gid * WGM, gsz = (nM - fm) < WGM ? (nM - fm) : WGM;
        u.pm = fm + ((wgid % nig) % gsz); u.pn = (wgid % nig) / gsz; return true;
    }
    __device__ __forceinline__ void a_ready(const Unit&) const {}
    __device__ __forceinline__ void done(const Unit&) const {}
};


__device__ __forceinline__ unsigned cvt_pk_bf16(float lo, float hi) {
    typedef float f2_t __attribute__((ext_vector_type(2))); typedef __bf16 b2_t __attribute__((ext_vector_type(2)));
    f2_t v = {lo, hi}; b2_t b = __builtin_convertvector(v, b2_t); return __builtin_bit_cast(unsigned, b); }
__device__ __forceinline__ u32x4 pack8(const f32x4 v0, const f32x4 v1) { u32x4 w; w.x = cvt_pk_bf16(v0[0], v0[1]); w.y = cvt_pk_bf16(v0[2], v0[3]); w.z = cvt_pk_bf16(v1[0], v1[1]); w.w = cvt_pk_bf16(v1[2], v1[3]); return w; }
constexpr float RMS_EPS = 1e-6f;
__device__ __forceinline__ float quad16_sum(float s) {
    const unsigned u0 = __builtin_bit_cast(unsigned, s); const auto r16 = __builtin_amdgcn_permlane16_swap(u0, u0, false, false);
    s = __builtin_bit_cast(float, (unsigned)r16[0]) + __builtin_bit_cast(float, (unsigned)r16[1]);
    const unsigned u1 = __builtin_bit_cast(unsigned, s); const auto r32 = __builtin_amdgcn_permlane32_swap(u1, u1, false, false);
    return __builtin_bit_cast(float, (unsigned)r32[0]) + __builtin_bit_cast(float, (unsigned)r32[1]);
}
__device__ __forceinline__ float row_rstd(const float* ss, int row, int fq) {
    const f32x4 v = *(const f32x4*)(ss + (size_t)row * 16 + 4 * fq);
    float s = (v[0] + v[1]) + (v[2] + v[3]);
    {
        const unsigned u0 = __builtin_bit_cast(unsigned, s); const auto r16 = __builtin_amdgcn_permlane16_swap(u0, u0, false, false);
        s = __builtin_bit_cast(float, (unsigned)r16[0]) + __builtin_bit_cast(float, (unsigned)r16[1]);
        const unsigned u1 = __builtin_bit_cast(unsigned, s); const auto r32 = __builtin_amdgcn_permlane32_swap(u1, u1, false, false);
        s = __builtin_bit_cast(float, (unsigned)r32[0]) + __builtin_bit_cast(float, (unsigned)r32[1]);
    }
    return rsqrtf(s * (1.0f / 1024.0f) + RMS_EPS);
}

struct EpiBf16X {
    static constexpr bool PERM = true, AFTER_DRAIN = false;
    bf16_t* O; int ldc; int split_cols; size_t split_stride;
    const float* ss; const float* rope; unsigned rope_mask; float* kmp;
    __device__ __forceinline__ void operator()(const f32x4 (&acc)[2][2][4][2], const Unit& u, int wr, int wc, int fr, int fq) const {
        const int row0 = u.pm * BM + wr * 64 + fr; int colt = u.pn * BM; bf16_t* base = O; int t = 0;
        if (split_cols) { t = colt / split_cols; base += (size_t)t * split_stride; colt -= t * split_cols; }
        const int col0 = colt + wc * 32 + 8 * fq;
        const bool do_rope = (rope != nullptr) && ((rope_mask >> t) & 1u);
        const bool do_km = (kmp != nullptr) && (t == 0);
        f32x4 ks[2][2];
#pragma unroll
        for (int bj = 0; bj < 2; ++bj)
#pragma unroll
            for (int n = 0; n < 2; ++n) ks[bj][n] = (f32x4){0.f, 0.f, 0.f, 0.f};
#pragma unroll
        for (int ai = 0; ai < 2; ++ai)
#pragma unroll
            for (int m = 0; m < 4; ++m) {
                const int row = row0 + ai * HALF + m * 16;
                const float rs = ss ? row_rstd(ss, row, fq) : 1.0f;
                f32x4 v[2][2];
#pragma unroll
                for (int bj = 0; bj < 2; ++bj)
#pragma unroll
                    for (int n = 0; n < 2; ++n) v[bj][n] = acc[ai][bj][m][n] * rs;
                if (do_rope && fq == 0) {
                    const float* cp = rope + (size_t)row * 32 + 8 * wc;
                    const f32x4 c0 = *(const f32x4*)(cp), c1 = *(const f32x4*)(cp + 4);
                    const float cs[8] = {c0[0], c0[1], c0[2], c0[3], c1[0], c1[1], c1[2], c1[3]};
#pragma unroll
                    for (int bj = 0; bj < 2; ++bj)
#pragma unroll
                        for (int j = 0; j < 4; ++j) { const float x1 = v[bj][0][j], x2 = v[bj][1][j], c = cs[2 * j], sn = cs[2 * j + 1];
                            v[bj][0][j] = x1 * c - x2 * sn; v[bj][1][j] = x2 * c + x1 * sn; }
                }
                if (do_km) {
#pragma unroll
                    for (int bj = 0; bj < 2; ++bj)
#pragma unroll
                        for (int n = 0; n < 2; ++n) ks[bj][n] += v[bj][n];
                }
                bf16_t* rowp = base + (size_t)row * ldc + col0;
#pragma unroll
                for (int bj = 0; bj < 2; ++bj) *(u32x4*)(rowp + bj * HALF) = pack8(v[bj][0], v[bj][1]);
            }
        if (do_km) {
#pragma unroll
            for (int bj = 0; bj < 2; ++bj)
#pragma unroll
                for (int n = 0; n < 2; ++n)
#pragma unroll
                    for (int j = 0; j < 4; ++j) { float s = ks[bj][n][j]; s += __shfl_xor(s, 1); s += __shfl_xor(s, 2); s += __shfl_xor(s, 4); s += __shfl_xor(s, 8); ks[bj][n][j] = s; }
            if (fr == 0) { float* kp = kmp + ((size_t)u.pm * 2 + wr) * 1024 + col0;
#pragma unroll
                for (int bj = 0; bj < 2; ++bj)
#pragma unroll
                    for (int n = 0; n < 2; ++n) *(f32x4*)(kp + bj * HALF + 4 * n) = ks[bj][n]; }
        }
    }
};

struct EpiMul {
    static constexpr bool PERM = true, AFTER_DRAIN = false;
    bf16_t* Z; bf16_t* BG; const float* ss;
    __device__ __forceinline__ void operator()(const f32x4 (&acc)[2][2][4][2], const Unit& u, int wr, int wc, int fr, int fq) const {
        const int row0 = u.pm * BM + wr * 64 + fr;
#pragma unroll
        for (int ai = 0; ai < 2; ++ai)
#pragma unroll
            for (int m = 0; m < 4; ++m) {
                const int row = row0 + ai * HALF + m * 16;
                const float rs = row_rstd(ss, row, fq);
                if (u.pn < 8) {
                    const float r2 = rs * rs;
                    const f32x4 z0 = acc[ai][0][m][0] * acc[ai][1][m][0] * r2, z1 = acc[ai][0][m][1] * acc[ai][1][m][1] * r2;
                    __builtin_nontemporal_store(pack8(z0, z1), (u32x4*)(Z + (size_t)row * 1024 + u.pn * 128 + wc * 32 + 8 * fq));
                } else {
                    bf16_t* rowp = BG + (size_t)row * 1024 + (u.pn - 8) * 256 + wc * 32 + 8 * fq;
#pragma unroll
                    for (int bj = 0; bj < 2; ++bj) __builtin_nontemporal_store(pack8(acc[ai][bj][m][0] * rs, acc[ai][bj][m][1] * rs), (u32x4*)(rowp + bj * HALF));
                }
            }
    }
};

struct EpiSwiGLU {
    static constexpr bool PERM = true, AFTER_DRAIN = false;
    bf16_t* ACT; int ldc; const float* ss;
    __device__ __forceinline__ void operator()(const f32x4 (&acc)[2][2][4][2], const Unit& u, int wr, int wc, int fr, int fq) const {
        const int row0 = u.pm * BM + u.roff * HALF + wr * 64 + fr;
#pragma unroll
        for (int ai = 0; ai < 2; ++ai)
          if (ai == 0 || !u.half)
#pragma unroll
            for (int m = 0; m < 4; ++m) {
                const int row = row0 + ai * HALF + m * 16;
                const float rs = row_rstd(ss, row, fq);
                f32x4 o[2];
#pragma unroll
                for (int n = 0; n < 2; ++n)
#pragma unroll
                    for (int j = 0; j < 4; ++j) { const float g = acc[ai][0][m][n][j] * rs, uu = acc[ai][1][m][n][j] * rs;
                        const float sg = g * __builtin_amdgcn_rcpf(1.0f + __builtin_amdgcn_exp2f(-1.4426950408889634f * g)); o[n][j] = sg * uu; }
                __builtin_nontemporal_store(pack8(o[0], o[1]), (u32x4*)(ACT + (size_t)row * ldc + u.pn * 128 + wc * 32 + 8 * fq));
            }
    }
};

struct EpiRes {
    static constexpr bool PERM = true, AFTER_DRAIN = false;
    const bf16_t* base; bf16_t* xb; float* ss;
    __device__ __forceinline__ void operator()(const f32x4 (&acc)[2][2][4][2], const Unit& u, int wr, int wc, int fr, int fq) const {
        const int row0 = u.pm * BM + wr * 64 + fr; const int col0 = u.pn * BM + wc * 32 + 8 * fq;
#pragma unroll
        for (int ai = 0; ai < 2; ++ai) {
            u32x4 bv[4][2];
#pragma unroll
            for (int m = 0; m < 4; ++m)
#pragma unroll
                for (int bj = 0; bj < 2; ++bj) bv[m][bj] = *(const u32x4*)(base + (size_t)(row0 + ai * HALF + m * 16) * 1024 + col0 + bj * HALF);
#pragma unroll
            for (int m = 0; m < 4; ++m) {
                const int row = row0 + ai * HALF + m * 16; const size_t off = (size_t)row * 1024 + col0; float sq = 0.f;
#pragma unroll
                for (int bj = 0; bj < 2; ++bj) {
                    const u32x4 b = bv[m][bj];
                    f32x4 b0, b1;
                    b0[0] = __builtin_bit_cast(float, b.x << 16); b0[1] = __builtin_bit_cast(float, b.x & 0xffff0000u); b0[2] = __builtin_bit_cast(float, b.y << 16); b0[3] = __builtin_bit_cast(float, b.y & 0xffff0000u);
                    b1[0] = __builtin_bit_cast(float, b.z << 16); b1[1] = __builtin_bit_cast(float, b.z & 0xffff0000u); b1[2] = __builtin_bit_cast(float, b.w << 16); b1[3] = __builtin_bit_cast(float, b.w & 0xffff0000u);
                    const f32x4 v0 = acc[ai][bj][m][0] + b0, v1 = acc[ai][bj][m][1] + b1;
                    *(u32x4*)(xb + off + bj * HALF) = pack8(v0, v1);
                    sq += (v0[0] * v0[0] + v0[1] * v0[1]) + (v0[2] * v0[2] + v0[3] * v0[3]) + (v1[0] * v1[0] + v1[1] * v1[1]) + (v1[2] * v1[2] + v1[3] * v1[3]);
                }
                sq = quad16_sum(sq);
                if (fq == 0) ss[(size_t)row * 16 + u.pn * 4 + wc] = sq;
            }
        }
    }
};

template <class Epi, class Sched, bool ALIGN_EPI = false, bool SP2 = false>
__device__ __forceinline__ void gemm_phase(PG8_LAS unsigned char* lds, const Gemm g, const Sched& S, const Epi& E, const int tid) {
    const int  wid = __builtin_amdgcn_readfirstlane(tid >> 6), lane = tid & 63, wr = wid >> 2, wc = wid & 3, fr = lane & 15, fq = lane >> 4;
    const int K = g.K, nt = K / BK;
    unsigned voffA[2], voffB[2];
#pragma unroll
    for (int i = 0; i < 2; ++i) { int R, C; stage_rc(tid * 16 + i * 8192, R, C); const int Rb = Epi::PERM ? ((R & ~31) + perm32(R & 31)) : R;
        voffA[i] = (unsigned)(R * K + C) * 2u; voffB[i] = (unsigned)(Rb * K + C) * 2u; }
    const size_t kstep = (size_t)(BK * 2);
    const size_t hstep = (size_t)HALF * K * 2;
    const size_t tstep = 2 * hstep;
    const unsigned ldsw = (unsigned)wid * 1024u;
    const int aoff = lds_byte(wr * 64 + fr, fq * 8), boff = lds_byte(wc * 32 + fr, fq * 8);
#define PG8_SA(b, h) (((b) * 2 + (h)) * HTB)
#define PG8_SB(b, h) ((4 + (b) * 2 + (h)) * HTB)
#define PG8_STAGE(bufoff, gbase, voff) do { _Pragma("unroll") for (int _i = 0; _i < 2; ++_i) \
        __builtin_amdgcn_global_load_lds((const unsigned*)((const char*)(gbase) + (voff)[_i]), (PG8_LAS unsigned*)(lds + (bufoff) + ldsw + _i * 8192), 16, 0, 0); } while (0)
#define PG8_LDA(dst, b, h) do { _Pragma("unroll") for (int m = 0; m < 4; ++m) _Pragma("unroll") for (int k = 0; k < 2; ++k) dst[m][k] = *(const PG8_LAS bf16x8*)(lds + PG8_SA(b, h) + aoff + m * 2048 + k * 1024); } while (0)
#define PG8_LDB(dst, b, h) do { _Pragma("unroll") for (int n = 0; n < 2; ++n) _Pragma("unroll") for (int k = 0; k < 2; ++k) dst[n][k] = *(const PG8_LAS bf16x8*)(lds + PG8_SB(b, h) + boff + n * 2048 + k * 1024); } while (0)
#define PG8_MMA(ai, bj, At, Bt) do { __builtin_amdgcn_s_setprio(1); _Pragma("unroll") for (int m = 0; m < 4; ++m) _Pragma("unroll") for (int n = 0; n < 2; ++n) _Pragma("unroll") for (int k = 0; k < 2; ++k) \
        acc[ai][bj][m][n] = __builtin_amdgcn_mfma_f32_16x16x32_bf16(Bt[n][k], At[m][k], acc[ai][bj][m][n], 0, 0, 0); __builtin_amdgcn_s_setprio(0); } while (0)
#define PG8_WAIT_V(n) asm volatile("s_waitcnt vmcnt(" #n ")" ::: "memory")
#define PG8_WAIT_L(n) asm volatile("s_waitcnt lgkmcnt(" #n ")" ::: "memory")
#define PG8_BAR __builtin_amdgcn_s_barrier()
#define PG8_SCHED __builtin_amdgcn_sched_barrier(0)
    Unit cur, nxt; int ui = 0;
    if (!S.next(0, cur)) return;
    f32x4 acc[2][2][4][2];
#pragma unroll
    for (int a = 0; a < 2; ++a)
#pragma unroll
        for (int b = 0; b < 2; ++b)
#pragma unroll
            for (int m = 0; m < 4; ++m)
#pragma unroll
                for (int n = 0; n < 2; ++n) acc[a][b][m][n] = (f32x4){0.f, 0.f, 0.f, 0.f};
    bf16x8 At[4][2], B0[2][2], B1[2][2];
    const char* cA = (const char*)g.A + (size_t)cur.pm * tstep + (size_t)cur.roff * hstep; const char* cB = (const char*)g.Bt + (size_t)cur.pn * tstep;
    S.a_ready(cur);
    if constexpr (SP2) {
        PG8_STAGE(PG8_SB(0, 0), cB, voffB); PG8_STAGE(PG8_SB(0, 1), cB + hstep, voffB); PG8_STAGE(PG8_SA(0, 0), cA, voffA); PG8_STAGE(PG8_SA(0, 1), cA + hstep, voffA);
        if (wr == 1) PG8_BAR;
        PG8_WAIT_V(2); PG8_BAR;
        PG8_STAGE(PG8_SB(1, 0), cB + kstep, voffB); PG8_STAGE(PG8_SA(1, 0), cA + kstep, voffA); PG8_STAGE(PG8_SB(1, 1), cB + hstep + kstep, voffB);
        PG8_WAIT_V(6); PG8_BAR;
    } else {
        PG8_STAGE(PG8_SB(0, 0), cB, voffB); PG8_STAGE(PG8_SA(0, 0), cA, voffA); PG8_STAGE(PG8_SB(0, 1), cB + hstep, voffB); PG8_STAGE(PG8_SA(0, 1), cA + hstep, voffA);
        if (wr == 1) PG8_BAR;
        PG8_WAIT_V(4); PG8_BAR;
        PG8_STAGE(PG8_SB(1, 0), cB + kstep, voffB); PG8_STAGE(PG8_SA(1, 0), cA + kstep, voffA); PG8_STAGE(PG8_SB(1, 1), cB + hstep + kstep, voffB);
        PG8_WAIT_V(6); PG8_BAR;
    }
    for (;;) {
        const bool has_next = S.next(ui + 1, nxt);
        const char* nA = has_next ? (const char*)g.A + (size_t)nxt.pm * tstep + (size_t)nxt.roff * hstep : cA; const char* nB = has_next ? (const char*)g.Bt + (size_t)nxt.pn * tstep : cB;
        for (int t = 0; t < nt; t += 2) {
            const bool last = (t == nt - 2);
            const char* a1 = cA + (size_t)(t + 1) * kstep;
            const char* a2 = last ? nA : cA + (size_t)(t + 2) * kstep; const char* b2 = last ? nB : cB + (size_t)(t + 2) * kstep;
            const char* a3 = a2 + kstep; const char* b3 = b2 + kstep;
            if (last && has_next) S.a_ready(nxt);
            if constexpr (SP2) {
            PG8_LDB(B0, 0, 0); PG8_LDB(B1, 0, 1); PG8_SCHED; PG8_LDA(At, 0, 0); PG8_STAGE(PG8_SA(1, 1), a1 + hstep, voffA);
            PG8_WAIT_V(8); PG8_WAIT_L(0); PG8_BAR; PG8_MMA(0, 0, At, B0); PG8_MMA(0, 1, At, B1); PG8_BAR; PG8_SCHED;
            PG8_LDA(At, 0, 1); PG8_STAGE(PG8_SB(0, 0), b2, voffB); PG8_STAGE(PG8_SB(0, 1), b2 + hstep, voffB); PG8_STAGE(PG8_SA(0, 0), a2, voffA);
            PG8_WAIT_V(8); PG8_WAIT_L(0); PG8_BAR; if (!cur.half) { PG8_MMA(1, 0, At, B0); PG8_MMA(1, 1, At, B1); } PG8_BAR; PG8_SCHED;
            PG8_LDB(B0, 1, 0); PG8_LDB(B1, 1, 1); PG8_SCHED; PG8_LDA(At, 1, 0); PG8_STAGE(PG8_SA(0, 1), a2 + hstep, voffA);
            PG8_WAIT_V(8); PG8_WAIT_L(0); PG8_BAR; PG8_MMA(0, 0, At, B0); PG8_MMA(0, 1, At, B1); PG8_BAR; PG8_SCHED;
            PG8_LDA(At, 1, 1); PG8_STAGE(PG8_SB(1, 0), b3, voffB); PG8_STAGE(PG8_SB(1, 1), b3 + hstep, voffB); PG8_STAGE(PG8_SA(1, 0), a3, voffA);
            PG8_WAIT_V(8); PG8_WAIT_L(0); PG8_BAR; if (!cur.half) { PG8_MMA(1, 0, At, B0); PG8_MMA(1, 1, At, B1); } PG8_BAR; PG8_SCHED;
            } else {
            PG8_LDB(B0, 0, 0); PG8_SCHED; PG8_LDA(At, 0, 0); PG8_STAGE(PG8_SA(1, 1), a1 + hstep, voffA);
            PG8_WAIT_L(8); PG8_BAR; PG8_WAIT_L(0); PG8_MMA(0, 0, At, B0); PG8_BAR; PG8_SCHED;
            PG8_LDB(B1, 0, 1); PG8_STAGE(PG8_SB(0, 0), b2, voffB);
            PG8_BAR; PG8_WAIT_L(0); PG8_MMA(0, 1, At, B1); PG8_BAR;
            PG8_LDA(At, 0, 1); PG8_STAGE(PG8_SA(0, 0), a2, voffA);
            PG8_BAR; PG8_WAIT_L(0); if (!cur.half) { PG8_MMA(1, 0, At, B0); } PG8_BAR; PG8_SCHED;
            PG8_STAGE(PG8_SB(0, 1), b2 + hstep, voffB);
            PG8_WAIT_V(6); PG8_BAR; if (!cur.half) { PG8_MMA(1, 1, At, B1); } PG8_BAR;
            PG8_LDB(B0, 1, 0); PG8_SCHED; PG8_LDA(At, 1, 0); PG8_STAGE(PG8_SA(0, 1), a2 + hstep, voffA);
            PG8_WAIT_L(8); PG8_BAR; PG8_WAIT_L(0); PG8_MMA(0, 0, At, B0); PG8_BAR; PG8_SCHED;
            PG8_LDB(B1, 1, 1); PG8_STAGE(PG8_SB(1, 0), b3, voffB);
            PG8_BAR; PG8_WAIT_L(0); PG8_MMA(0, 1, At, B1); PG8_BAR;
            PG8_LDA(At, 1, 1); PG8_STAGE(PG8_SA(1, 0), a3, voffA);
            PG8_BAR; PG8_WAIT_L(0); if (!cur.half) { PG8_MMA(1, 0, At, B0); } PG8_BAR; PG8_SCHED;
            PG8_STAGE(PG8_SB(1, 1), b3 + hstep, voffB);
            PG8_WAIT_V(6); PG8_BAR; if (!cur.half) { PG8_MMA(1, 1, At, B1); } PG8_BAR;
            }
        }
        if constexpr (ALIGN_EPI) { if (wr == 0) PG8_BAR; }
        if constexpr (!Epi::AFTER_DRAIN) { E(acc, cur, wr, wc, fr, fq); S.done(cur); }
        if (!has_next) break;
#pragma unroll
        for (int a = 0; a < 2; ++a)
#pragma unroll
            for (int b = 0; b < 2; ++b)
#pragma unroll
                for (int m = 0; m < 4; ++m)
#pragma unroll
                    for (int n = 0; n < 2; ++n) acc[a][b][m][n] = (f32x4){0.f, 0.f, 0.f, 0.f};
        cur = nxt; cA = nA; cB = nB; ++ui;
        if constexpr (ALIGN_EPI) { if (wr == 1) PG8_BAR; }
    }
    PG8_WAIT_V(0);
    if constexpr (!ALIGN_EPI) { if (wr == 0) PG8_BAR; }
    PG8_BAR;
    if constexpr (Epi::AFTER_DRAIN) { E.fused(acc, cur, wr, wc, fr, fq, lds, wid, lane); S.done(cur); }
#undef PG8_SA
#undef PG8_SB
#undef PG8_STAGE
#undef PG8_LDA
#undef PG8_LDB
#undef PG8_MMA
#undef PG8_WAIT_V
#undef PG8_WAIT_L
#undef PG8_BAR
#undef PG8_SCHED
}
}

#define GAS __attribute__((address_space(1)))
#define LAS __attribute__((address_space(3)))
typedef unsigned short bf16;
typedef float f32x4 __attribute__((ext_vector_type(4)));
typedef float f32x16 __attribute__((ext_vector_type(16)));
typedef short bf16x8 __attribute__((ext_vector_type(8)));
typedef short s16x4 __attribute__((ext_vector_type(4)));
typedef unsigned u32x4 __attribute__((ext_vector_type(4)));
typedef unsigned u32x2 __attribute__((ext_vector_type(2)));

constexpr int BATCH = 4, SEQ = 4096, D = 1024, T = BATCH * SEQ, DFF = 2816, MEML = 256, MEMT = BATCH * MEML;
constexpr int NH = 8, HD = 128, MH = 4, MHD = 256, NBLK = SEQ / 256;
constexpr float LOG2E = 1.4426950408889634f;
constexpr float QS_MOBA = 0.08838834764831845f * LOG2E;
constexpr float QS_MEM = 0.0625f * LOG2E;
constexpr int NTHREADS = 512, NWAVES = 8;
constexpr int LDS_BYTES = 131072 + 1024 + 16384;

constexpr size_t MiB = 1u << 20;
constexpr size_t WS_WIN = 0;
constexpr size_t WS_WOUT = WS_WIN + 6 * MiB;
constexpr size_t WS_MWQ = WS_WOUT + 2 * MiB;
constexpr size_t WS_MWKV = WS_MWQ + 4 * MiB;
constexpr size_t WS_MWO = WS_MWKV + 8 * MiB;
constexpr size_t WGU_BYTES = (size_t)2 * DFF * D * 2;
constexpr size_t WS_WGU = WS_MWO + 4 * MiB;
constexpr size_t WDN_BYTES = (size_t)D * DFF * 2;
constexpr size_t WS_WDN = WS_WGU + 2 * WGU_BYTES;
constexpr size_t WS_WKVQ = WS_WDN + 2 * WDN_BYTES;
constexpr size_t WS_MOWO = WS_WKVQ + 6 * MiB;
constexpr size_t WS_XB = 68 * MiB;
static_assert(WS_MOWO + 2 * MiB <= WS_XB, "weights fit");
constexpr size_t WS_R = WS_XB + 32 * MiB;
constexpr size_t WS_R0 = WS_R, WS_R1 = WS_R + 32 * MiB, WS_R2 = WS_R + 64 * MiB;
constexpr size_t WS_SMALL = WS_R + 96 * MiB;
constexpr size_t WS_SS = WS_SMALL;
constexpr size_t WS_KVM = WS_SS + 1 * MiB;
constexpr size_t WS_MEMN = WS_KVM + 8 * MiB;
constexpr size_t WS_KMP = WS_MEMN + 4 * MiB;
constexpr size_t WS_ROPE = WS_KMP + 1 * MiB;
constexpr size_t WS_BAR = WS_ROPE + 2 * MiB;
constexpr size_t WS_END = WS_BAR + 1 * MiB;
static_assert(WS_END <= 256 * MiB, "d_ws map");

__device__ __forceinline__ float bf2f(unsigned short b) { return __builtin_bit_cast(float, (unsigned)b << 16); }
__device__ __forceinline__ float wave_sum(float v) {
#pragma unroll
    for (int o = 1; o < 64; o <<= 1) v += __shfl_xor(v, o);
    return v;
}

#define MFMA32(a, b, c) __builtin_amdgcn_mfma_f32_32x32x16_bf16((a), (b), (c), 0, 0, 0)
__device__ __forceinline__ s16x4 vtr(LAS const char* p) { return __builtin_bit_cast(s16x4, __builtin_amdgcn_ds_read_tr16_b64_v4i16((LAS s16x4*)p)); }

template <int DQK, int VW, int KT> struct ATile {
    static constexpr int KCH = DQK / 8, VCH = VW / 8;
    static constexpr int NK = KT * KCH / NTHREADS, NV = KT * VCH / NTHREADS;
    static constexpr int KBYTES = KT * DQK * 2, VBYTES = KT * VW * 2, STAGE = KBYTES + VBYTES;
    static_assert(NK >= 1 && NV >= 1, "tile too small for 512 threads");
    u32x4 kr[NK], vr[NV];
    __device__ __forceinline__ void load(const bf16* Kg, size_t kpitch, const bf16* Vg, size_t vpitch, int tid) {
#pragma unroll
        for (int i = 0; i < NK; ++i) { const int idx = tid + i * NTHREADS, row = idx / KCH, c = idx % KCH; kr[i] = *(const u32x4*)(Kg + (size_t)row * kpitch + c * 8); }
#pragma unroll
        for (int i = 0; i < NV; ++i) { const int idx = tid + i * NTHREADS, row = idx / VCH, c = idx % VCH; vr[i] = *(const u32x4*)(Vg + (size_t)row * vpitch + c * 8); }
    }
    __device__ __forceinline__ void store(LAS char* stage, int tid) const {
#pragma unroll
        for (int i = 0; i < NK; ++i) { const int idx = tid + i * NTHREADS, row = idx / KCH, c = idx % KCH; *(LAS u32x4*)(stage + row * (DQK * 2) + ((c ^ (row & 15)) << 4)) = kr[i]; }
#pragma unroll
        for (int i = 0; i < NV; ++i) { const int idx = tid + i * NTHREADS, row = idx / VCH, c = idx % VCH; *(LAS u32x4*)(stage + KBYTES + row * (VW * 2) + ((c ^ (4 * (row & 3))) << 4)) = vr[i]; }
    }
};

template <int DQK, int VW, int KT>
__device__ __forceinline__ void attn_tile(LAS const char* kb, LAS const char* vb, const bf16x8 (&qf)[DQK / 16], f32x16 (&o)[4], float& m, float& l, int voff, int lane, int lim, const int MODE  , const int pvar = 0) {
    constexpr int NSUB = KT / 32;
    const int r = lane & 31, h = lane >> 5;
    f32x16 st[NSUB];
#pragma unroll
    for (int sub = 0; sub < NSUB; ++sub)
#pragma unroll
        for (int i = 0; i < 16; ++i) st[sub][i] = 0.f;
#ifdef PROBE_VARIANTS
    if (pvar != 3)
#endif
#pragma unroll
    for (int s = 0; s < DQK / 16; ++s)
#pragma unroll
        for (int sub = 0; sub < NSUB; ++sub) {
            const int row = sub * 32 + r;
            const bf16x8 kf = *(LAS const bf16x8*)(kb + row * (DQK * 2) + (((2 * s + h) ^ (row & 15)) << 4));
            st[sub] = MFMA32(kf, qf[s], st[sub]);
        }
#ifdef PROBE_VARIANTS
    if (pvar != 1) {
#else
    {
#endif
    const float ninf = -__builtin_inff();
    if (MODE == 1) {
        const int lm = lim - 4 * h;
#pragma unroll
        for (int sub = 0; sub < NSUB; ++sub)
#pragma unroll
            for (int i = 0; i < 16; ++i) { const int kc = sub * 32 + (i & 3) + 8 * (i >> 2); st[sub][i] = (kc <= lm) ? st[sub][i] : ninf; }
    }
    float mx = ninf;
#pragma unroll
    for (int sub = 0; sub < NSUB; ++sub)
#pragma unroll
        for (int i = 0; i < 16; ++i) mx = fmaxf(mx, st[sub][i]);
    mx = fmaxf(mx, __shfl_xor(mx, 32));
    float mnew = fmaxf(m, mx);
    float msafe = (mnew == ninf) ? 0.f : mnew;
    float mal = msafe;
    if (MODE == 2) { const bool rs = lim >= 0; mnew = rs ? mnew : m; mal = mnew; msafe = rs ? mnew : __builtin_inff(); }
    const float alpha = __builtin_amdgcn_exp2f(m - mal);
    float ps = 0.f;
#pragma unroll
    for (int sub = 0; sub < NSUB; ++sub)
#pragma unroll
        for (int i = 0; i < 16; ++i) { const float p = __builtin_amdgcn_exp2f(st[sub][i] - msafe); st[sub][i] = p; ps += p; }
    l = l * alpha + ps; m = mnew;
    if (__ballot(alpha != 1.0f) != 0ull) {
#pragma unroll
        for (int d = 0; d < 4; ++d) o[d] = o[d] * alpha;
    }
    }
    bf16x8 pf[KT / 16];
#pragma unroll
    for (int sub = 0; sub < NSUB; ++sub)
#pragma unroll
        for (int s = 0; s < 2; ++s) {
            u32x4 p; p.x = pg8::cvt_pk_bf16(st[sub][8 * s + 0], st[sub][8 * s + 1]); p.y = pg8::cvt_pk_bf16(st[sub][8 * s + 2], st[sub][8 * s + 3]);
            p.z = pg8::cvt_pk_bf16(st[sub][8 * s + 4], st[sub][8 * s + 5]); p.w = pg8::cvt_pk_bf16(st[sub][8 * s + 6], st[sub][8 * s + 7]);
            pf[sub * 2 + s] = __builtin_bit_cast(bf16x8, p);
        }
    const int i16 = lane & 15, q4 = i16 >> 2, p4 = i16 & 3, g = (lane >> 4) & 1;
#ifdef PROBE_VARIANTS
    if (pvar != 2)
#endif
#pragma unroll
    for (int ks = 0; ks < KT / 16; ++ks) {
        const int rlo = ks * 16 + 4 * h + q4, rhi = rlo + 8;
#pragma unroll
        for (int d = 0; d < 4; ++d) {
            const int c = (voff + d * 32 + 16 * g) >> 3;
            const s16x4 lo = vtr(vb + rlo * (VW * 2) + ((c ^ (4 * (rlo & 3))) << 4) + 8 * p4);
            const s16x4 hi = vtr(vb + rhi * (VW * 2) + ((c ^ (4 * (rhi & 3))) << 4) + 8 * p4);
            const bf16x8 vf = __builtin_shufflevector(lo, hi, 0, 1, 2, 3, 4, 5, 6, 7);
            o[d] = MFMA32(vf, pf[ks], o[d]);
        }
    }
}

__device__ __forceinline__ void attn_store(LAS char* wl, bf16* Orow0, const f32x16 (&o)[4], float l, int lane) {
    const int r = lane & 31, h = lane >> 5;
    l += __shfl_xor(l, 32);
    const float inv = 1.0f / l;
#pragma unroll
    for (int hh = 0; hh < 2; ++hh) {
#pragma unroll
        for (int dd = 0; dd < 2; ++dd)
#pragma unroll
            for (int g4 = 0; g4 < 4; ++g4) {
                const int d = 2 * hh + dd, c = 4 * dd + g4;
                u32x2 w; w.x = pg8::cvt_pk_bf16(o[d][4 * g4 + 0] * inv, o[d][4 * g4 + 1] * inv); w.y = pg8::cvt_pk_bf16(o[d][4 * g4 + 2] * inv, o[d][4 * g4 + 3] * inv);
                *(LAS u32x2*)(wl + r * 128 + ((c ^ (r & 7)) << 4) + 8 * h) = w;
            }
#pragma unroll
        for (int k = 0; k < 4; ++k) {
            const int idx = lane + 64 * k, row = idx >> 3, c = idx & 7;
            const u32x4 v = *(LAS const u32x4*)(wl + row * 128 + ((c ^ (row & 7)) << 4));
            __builtin_nontemporal_store(v, (u32x4*)(Orow0 + (size_t)row * D + hh * 64 + c * 8));
        }
    }
}

__device__ __forceinline__ void glds16(const void* gsrc, unsigned lds_dst) { unsigned keep;
    asm volatile("s_mov_b32 %0, m0\n\ts_mov_b32 m0, %2\n\ts_nop 0\n\tglobal_load_lds_dwordx4 %1, off\n\ts_mov_b32 m0, %0" : "=&s"(keep) : "v"(gsrc), "s"(lds_dst) : "memory"); }
__device__ __forceinline__ void memattn_phase(LAS char* lds, const bf16* QM, const bf16* KVM, bf16* AO, const pg8::StaticOrder S, int tid_in) {
    pg8::Unit un;
    for (int ui = 0; S.next(ui, un); ++ui) {
        int tid = tid_in; asm volatile("" : "+v"(tid));
        const int lane = tid & 63, w = tid >> 6, r = lane & 31, h = lane >> 5;
        const int b = un.pm / (SEQ / 256), grp = un.pm % (SEQ / 256), hd = un.pn;
        const size_t tok = (size_t)b * SEQ + grp * 256 + w * 32 + r;
        const bf16* Kg = KVM + (size_t)(b * MEML) * 2048 + hd * MHD; const bf16* Vg = Kg + 1024;
        {
            const int wu = __builtin_amdgcn_readfirstlane(w);
            const unsigned sbase = (unsigned)(size_t)lds;
#pragma unroll
            for (int i = 0; i < 16; ++i) {
                const int row = 32 * w + 2 * i + (lane >> 5), cp = lane & 31;
                glds16(Kg + (size_t)row * 2048 + (cp ^ (row & 15)) * 8, __builtin_amdgcn_readfirstlane(sbase + (32 * wu + 2 * i) * 512));
            }
        }
        bf16x8 qf[16];
#pragma unroll
        for (int s = 0; s < 16; ++s) qf[s] = *(const bf16x8*)(QM + tok * D + hd * MHD + 16 * s + 8 * h);
        asm volatile("s_waitcnt vmcnt(0)" ::: "memory");
        __syncthreads();
        float mx = -__builtin_inff();
#pragma unroll
        for (int tp = 0; tp < 1; ++tp) {
            f32x16 s0, s1;
#pragma unroll
            for (int i = 0; i < 16; ++i) { s0[i] = 0.f; s1[i] = 0.f; }
            const int row0 = tp * 64 + r, row1 = row0 + 32;
#pragma unroll
            for (int s = 0; s < 16; ++s) {
                const bf16x8 k0 = *(LAS const bf16x8*)(lds + row0 * 512 + (((2 * s + h) ^ (row0 & 15)) << 4));
                const bf16x8 k1 = *(LAS const bf16x8*)(lds + row1 * 512 + (((2 * s + h) ^ (row1 & 15)) << 4));
                s0 = MFMA32(k0, qf[s], s0); s1 = MFMA32(k1, qf[s], s1);
            }
#pragma unroll
            for (int i = 0; i < 16; ++i) mx = fmaxf(mx, fmaxf(s0[i], s1[i]));
        }
        mx = fmaxf(mx, __shfl_xor(mx, 32));
        float l = 0.f;
        bf16x8 pf[16];
#pragma unroll
        for (int tp = 0; tp < 4; ++tp) {
            f32x16 s0, s1;
#pragma unroll
            for (int i = 0; i < 16; ++i) { s0[i] = 0.f; s1[i] = 0.f; }
            const int row0 = tp * 64 + r, row1 = row0 + 32;
#pragma unroll
            for (int s = 0; s < 16; ++s) {
                const bf16x8 k0 = *(LAS const bf16x8*)(lds + row0 * 512 + (((2 * s + h) ^ (row0 & 15)) << 4));
                const bf16x8 k1 = *(LAS const bf16x8*)(lds + row1 * 512 + (((2 * s + h) ^ (row1 & 15)) << 4));
                s0 = MFMA32(k0, qf[s], s0); s1 = MFMA32(k1, qf[s], s1);
            }
#pragma unroll
            for (int i = 0; i < 16; ++i) { s0[i] = __builtin_amdgcn_exp2f(s0[i] - mx); s1[i] = __builtin_amdgcn_exp2f(s1[i] - mx); l += s0[i] + s1[i]; }
#pragma unroll
            for (int sh = 0; sh < 2; ++sh) {
                u32x4 p0, p1;
                p0.x = pg8::cvt_pk_bf16(s0[8 * sh + 0], s0[8 * sh + 1]); p0.y = pg8::cvt_pk_bf16(s0[8 * sh + 2], s0[8 * sh + 3]); p0.z = pg8::cvt_pk_bf16(s0[8 * sh + 4], s0[8 * sh + 5]); p0.w = pg8::cvt_pk_bf16(s0[8 * sh + 6], s0[8 * sh + 7]);
                p1.x = pg8::cvt_pk_bf16(s1[8 * sh + 0], s1[8 * sh + 1]); p1.y = pg8::cvt_pk_bf16(s1[8 * sh + 2], s1[8 * sh + 3]); p1.z = pg8::cvt_pk_bf16(s1[8 * sh + 4], s1[8 * sh + 5]); p1.w = pg8::cvt_pk_bf16(s1[8 * sh + 6], s1[8 * sh + 7]);
                pf[tp * 4 + sh] = __builtin_bit_cast(bf16x8, p0); pf[tp * 4 + 2 + sh] = __builtin_bit_cast(bf16x8, p1);
            }
        }
        l += __shfl_xor(l, 32);
        __syncthreads();
        int tid2 = tid_in; asm volatile("" : "+v"(tid2));
        {
            const int w2 = tid2 >> 6, l2 = tid2 & 63, wu2 = __builtin_amdgcn_readfirstlane(w2);
            const unsigned sbase = (unsigned)(size_t)lds;
#pragma unroll
            for (int i = 0; i < 16; ++i) {
                const int row = 32 * w2 + 2 * i + (l2 >> 5), cp = l2 & 31;
                glds16(Vg + (size_t)row * 2048 + (cp ^ (4 * (row & 3))) * 8, __builtin_amdgcn_readfirstlane(sbase + (32 * wu2 + 2 * i) * 512));
            }
        }
        asm volatile("s_waitcnt vmcnt(0)" ::: "memory");
        __syncthreads();
        const float inv = 1.0f / l;
        const int lane2 = tid2 & 63, h2 = lane2 >> 5;
        bf16* Og = AO + ((size_t)b * SEQ + grp * 256 + (tid2 >> 6) * 32 + (lane2 & 31)) * D + hd * MHD;
        const int i16 = lane2 & 15, q4 = i16 >> 2, p4 = i16 & 3, g = (lane2 >> 4) & 1;
#pragma unroll
        for (int dh = 0; dh < 2; ++dh) {
            f32x16 o[4];
#pragma unroll
            for (int d = 0; d < 4; ++d)
#pragma unroll
                for (int i = 0; i < 16; ++i) o[d][i] = 0.f;
#pragma unroll
            for (int ks = 0; ks < 16; ++ks) {
                const int rlo = ks * 16 + 4 * h2 + q4, rhi = rlo + 8;
#pragma unroll
                for (int d = 0; d < 4; ++d) {
                    const int cc = ((dh * 4 + d) * 32 + 16 * g) >> 3;
                    const s16x4 lo = vtr(lds + rlo * 512 + ((cc ^ (4 * (rlo & 3))) << 4) + 8 * p4);
                    const s16x4 hi = vtr(lds + rhi * 512 + ((cc ^ (4 * (rhi & 3))) << 4) + 8 * p4);
                    const bf16x8 vf = __builtin_shufflevector(lo, hi, 0, 1, 2, 3, 4, 5, 6, 7);
                    o[d] = MFMA32(vf, pf[ks], o[d]);
                }
            }
            {
                LAS char* wl = lds + 131072 + 1024 + (tid2 >> 6) * 2048;
                const int r2 = lane2 & 31;
                bf16* Orow0 = AO + ((size_t)b * SEQ + grp * 256 + (tid2 >> 6) * 32) * D + hd * MHD;
#pragma unroll
                for (int d = 0; d < 4; ++d) {
#pragma unroll
                    for (int g4 = 0; g4 < 4; ++g4) {
                        u32x2 wv; wv.x = pg8::cvt_pk_bf16(o[d][4 * g4 + 0] * inv, o[d][4 * g4 + 1] * inv); wv.y = pg8::cvt_pk_bf16(o[d][4 * g4 + 2] * inv, o[d][4 * g4 + 3] * inv);
                        *(LAS u32x2*)(wl + r2 * 64 + ((g4 ^ (r2 & 3)) << 4) + 8 * h2) = wv;
                    }
#pragma unroll
                    for (int k = 0; k < 2; ++k) {
                        const int idx = lane2 + 64 * k, row = idx >> 2, c = idx & 3;
                        const u32x4 v = *(LAS const u32x4*)(wl + row * 64 + ((c ^ (row & 3)) << 4));
                        __builtin_nontemporal_store(v, (u32x4*)(Orow0 + (size_t)row * D + (dh * 4 + d) * 32 + c * 8));
                    }
                }
            }
        }
        __syncthreads();
    }
}

__device__ __forceinline__ void moba_dma(LAS char* stage, const bf16* Kt, const bf16* Vt, int w, int lane) {
    const unsigned sbase = (unsigned)(size_t)stage;
#pragma unroll
    for (int i = 0; i < 2; ++i) {
        const int row = w * 8 + i * 4 + (lane >> 4), cp = lane & 15;
        const int ck = cp ^ (row & 15), cv = cp ^ (4 * (row & 3));
        glds16(Kt + (size_t)row * D + ck * 8, __builtin_amdgcn_readfirstlane(sbase + (w * 8 + i * 4) * 256));
        glds16(Vt + (size_t)row * D + cv * 8, __builtin_amdgcn_readfirstlane(sbase + 16384 + (w * 8 + i * 4) * 256));
    }
}

__device__ __forceinline__ void moba_phase(LAS char* lds, const bf16* QB, const bf16* KB, const bf16* VB, bf16* AO, const float* kmp, int G, int c, int tid_in, const int pvar = 0) {
    typedef ATile<128, 128, 64> TL;
    for (int u = c; u < 2 * BATCH * NH * 8; u += G) {
        int tid = tid_in; asm volatile("" : "+v"(tid));
        const int lane = tid & 63, w = tid >> 6, r = lane & 31, h = lane >> 5;
        const int uu = (u < 256) ? u : (u - 256);
        const int bh = uu >> 3, qb = (u < 256) ? (15 - (uu & 7)) : (uu & 7), b = bh / NH, hd = bh % NH;
        const size_t tok = (size_t)b * SEQ + qb * 256 + w * 32 + r;
        const bf16* Kh = KB + (size_t)b * SEQ * D + hd * HD; const bf16* Vh = VB + (size_t)b * SEQ * D + hd * HD;
        const int wu = __builtin_amdgcn_readfirstlane(w);
        constexpr int STG = 32768;
#define MOBA_TILE_OFF(n) ((size_t)((((n) < 4) ? qb : (((n) - 4) >> 2)) * 256 + ((n) & 3) * 64) * D)
        moba_dma(lds, Kh + MOBA_TILE_OFF(0), Vh + MOBA_TILE_OFF(0), wu, lane);
        moba_dma(lds + STG, Kh + MOBA_TILE_OFF(1), Vh + MOBA_TILE_OFF(1), wu, lane);
        bf16x8 qf[8];
#pragma unroll
        for (int s = 0; s < 8; ++s) qf[s] = *(const bf16x8*)(QB + tok * D + hd * HD + 16 * s + 8 * h);
        unsigned sel = 0u;
#ifdef PROBE_VARIANTS
        if (qb > 0 && pvar != 7) {
#else
        if (qb > 0) {
#endif
            LAS char* gfr = lds + 3 * 32768;
            {
                const int jb = r & 15;
                const float* p0 = kmp + ((size_t)(b * NBLK + jb) * 2) * 1024 + hd * HD + 16 * w + 8 * h;
                const f32x4 a0 = *(const f32x4*)p0, a1 = *(const f32x4*)(p0 + 4), b0 = *(const f32x4*)(p0 + 1024), b1 = *(const f32x4*)(p0 + 1028);
                const f32x4 k0 = (a0 + b0) * (1.0f / 256.0f), k1 = (a1 + b1) * (1.0f / 256.0f);
                const u32x4 hi = pg8::pack8(k0, k1);
                f32x4 h0, h1;
                h0[0] = __builtin_bit_cast(float, hi.x << 16); h0[1] = __builtin_bit_cast(float, hi.x & 0xffff0000u); h0[2] = __builtin_bit_cast(float, hi.y << 16); h0[3] = __builtin_bit_cast(float, hi.y & 0xffff0000u);
                h1[0] = __builtin_bit_cast(float, hi.z << 16); h1[1] = __builtin_bit_cast(float, hi.z & 0xffff0000u); h1[2] = __builtin_bit_cast(float, hi.w << 16); h1[3] = __builtin_bit_cast(float, hi.w & 0xffff0000u);
                const u32x4 lo = pg8::pack8(k0 - h0, k1 - h1);
                *(LAS u32x4*)(gfr + (w * 64 + lane) * 16) = (r < 16) ? hi : lo;
            }
            __syncthreads();
            f32x16 gt;
#pragma unroll
            for (int i = 0; i < 16; ++i) gt[i] = 0.f;
#pragma unroll
            for (int s = 0; s < 8; ++s) gt = MFMA32(*(LAS const bf16x8*)(gfr + (s * 64 + lane) * 16), qf[s], gt);
#pragma unroll
            for (int i = 0; i < 8; ++i) gt[i] += gt[i + 8];
            float mine[8], oth[8];
#pragma unroll
            for (int i = 0; i < 8; ++i) { mine[i] = gt[i]; oth[i] = __shfl_xor(gt[i], 32); }
#pragma unroll
            for (int rep = 0; rep < 3; ++rep) {
                float best = -__builtin_inff(); int bi = -1;
#pragma unroll
                for (int i = 0; i < 8; ++i) {
                    const int b1 = (i & 3) + 8 * (i >> 2) + 4 * h, b2 = (i & 3) + 8 * (i >> 2) + 4 * (1 - h);
                    const bool ok1 = (b1 < qb) && !((sel >> b1) & 1u); if (ok1 && (bi < 0 || mine[i] > best)) { best = mine[i]; bi = b1; }
                    const bool ok2 = (b2 < qb) && !((sel >> b2) & 1u); if (ok2 && (bi < 0 || oth[i] > best)) { best = oth[i]; bi = b2; }
                }
                if (bi >= 0) sel |= 1u << bi;
            }
        }
        f32x16 o[4];
#pragma unroll
        for (int d = 0; d < 4; ++d)
#pragma unroll
            for (int i = 0; i < 16; ++i) o[d][i] = 0.f;
        float m = -__builtin_inff(), l = 0.f;
#ifdef PROBE_VARIANTS
        const int NT = (pvar == 4 || pvar == 7 || pvar == 8) ? 0 : 4 * (qb + 1);
#elif defined(PROBE_HALF_TILES)
        const int NT = 4 + 2 * qb;
#else
        const int NT = 4 * (qb + 1);
#endif
        __builtin_amdgcn_s_waitcnt(0);
        const int qloc = w * 32 + r;
        for (int pp = 0; 2 * pp < NT; ++pp) {
            asm volatile("s_waitcnt vmcnt(0)" ::: "memory");
            __builtin_amdgcn_s_barrier();
            if (2 * pp + 2 < NT) { const int n = 2 * pp + 2; LAS char* sn = lds + ((pp + 1) & 1) * 65536;
                moba_dma(sn, Kh + MOBA_TILE_OFF(n), Vh + MOBA_TILE_OFF(n), wu, lane); moba_dma(sn + STG, Kh + MOBA_TILE_OFF(n + 1), Vh + MOBA_TILE_OFF(n + 1), wu, lane); }
#pragma unroll
            for (int hh = 0; hh < 2; ++hh) {
                const int it = 2 * pp + hh;
                LAS const char* st = lds + (pp & 1) * 65536 + hh * STG;
                const int kt = it & 3;
                int lim; bool active;
                if (it < 4) { lim = qloc - kt * 64; active = (kt * 64 <= w * 32 + 31); }
                else { const int j = (it - 4) >> 2; const bool s1 = (sel >> j) & 1u; lim = s1 ? (1 << 30) : -1; active = (__ballot(s1) != 0ull); }
#ifdef PROBE_VARIANTS
                if (pvar == 5) active = false;
#endif
                if (active) {
                    const int mode = (it >= 4) ? 2 : ((kt * 64 + 63 > w * 32) ? 1 : 0);
                    attn_tile<128, 128, 64>(st, st + 16384, qf, o, m, l, 0, lane, lim, mode, pvar);
                }
            }
        }
#undef MOBA_TILE_OFF
        __builtin_amdgcn_s_barrier();
#ifdef PROBE_VARIANTS
        if (pvar != 8)
#endif
        attn_store(lds + 65536 + w * 4096, AO + (tok - r) * D + hd * HD, o, l, lane);
    }
}

__host__ __device__ __forceinline__ int hperm(int d) {
    if (d < 16) return 32 * (d >> 2) + (d & 3);
    if (d < 32) return 32 * ((d - 16) >> 2) + 4 + (d & 3);
    const int k = d - 32; return 32 * (k / 24) + 8 + (k % 24);
}
__device__ __forceinline__ void transpose_item(const float* W, int K, int N, const float* gain, float scale, bf16* WT, int k0, int n0, int drow0, int lane, const bool hp = false) {
    const int q = lane >> 4, c = lane & 15;
    const float* src = W + (size_t)(k0 + 16 * q) * N + n0 + 4 * c;
    f32x4 v[16];
#pragma unroll
    for (int j = 0; j < 16; ++j) v[j] = __builtin_nontemporal_load((const f32x4*)(src + (size_t)j * N));
    float gs[16];
    if (gain) {
#pragma unroll
        for (int j4 = 0; j4 < 4; ++j4) { const f32x4 gv = *(const f32x4*)(gain + k0 + 16 * q + 4 * j4); gs[4 * j4] = gv[0] * scale; gs[4 * j4 + 1] = gv[1] * scale; gs[4 * j4 + 2] = gv[2] * scale; gs[4 * j4 + 3] = gv[3] * scale; }
    } else {
#pragma unroll
        for (int j = 0; j < 16; ++j) gs[j] = scale;
    }
#pragma unroll
    for (int e = 0; e < 4; ++e) {
        u32x4 lo, hi;
        lo.x = pg8::cvt_pk_bf16(v[0][e] * gs[0], v[1][e] * gs[1]); lo.y = pg8::cvt_pk_bf16(v[2][e] * gs[2], v[3][e] * gs[3]);
        lo.z = pg8::cvt_pk_bf16(v[4][e] * gs[4], v[5][e] * gs[5]); lo.w = pg8::cvt_pk_bf16(v[6][e] * gs[6], v[7][e] * gs[7]);
        hi.x = pg8::cvt_pk_bf16(v[8][e] * gs[8], v[9][e] * gs[9]); hi.y = pg8::cvt_pk_bf16(v[10][e] * gs[10], v[11][e] * gs[11]);
        hi.z = pg8::cvt_pk_bf16(v[12][e] * gs[12], v[13][e] * gs[13]); hi.w = pg8::cvt_pk_bf16(v[14][e] * gs[14], v[15][e] * gs[15]);
        const int dr = hp ? ((drow0 & ~127) + hperm((drow0 & 127) + 4 * c + e)) : (drow0 + 4 * c + e);
        bf16* dst = WT + (size_t)dr * K + k0 + 16 * q;
        *(u32x4*)dst = lo; *(u32x4*)(dst + 8) = hi;
    }
}

struct Args { const void* in[20]; float* out; unsigned char* ws; int ph_lo, ph_hi; };

__device__ __forceinline__ void prologue(const Args& a, LAS char* lds, int G, int c, int tid) {
    const int lane = tid & 63, w = tid >> 6;
    const int gw = c * NWAVES + w, NGW = G * NWAVES;
    unsigned char* ws = a.ws;
    const float* norm_mix = (const float*)a.in[3]; const float* norm_mem = (const float*)a.in[4]; const float* norm_memkv = (const float*)a.in[5]; const float* norm_ffn = (const float*)a.in[6];
    constexpr int I_IN = 16 * 48, I_SQ = 16 * 16, I_KV = 16 * 32, I_GU = 16 * 88, I_DN = 44 * 16;
    constexpr int NITEMS = I_IN + 7 * I_SQ + 3 * I_KV + 2 * I_GU + 2 * I_DN;
    for (int it = gw; it < NITEMS; it += NGW) {
        int rr = it; const float* W; int K, N; const float* gain = nullptr; float scale = 1.f; bf16* WT; int mode = 0;
        if (rr < I_IN) { W = (const float*)a.in[8]; K = D; N = 3 * D; gain = norm_mix; WT = (bf16*)(ws + WS_WIN); mode = 1; }
        else if ((rr -= I_IN) < I_SQ) { W = (const float*)a.in[10]; K = D; N = D; WT = (bf16*)(ws + WS_WOUT); }
        else if ((rr -= I_SQ) < 2 * I_SQ) { const int l = rr / I_SQ; rr -= l * I_SQ; W = (const float*)a.in[15] + (size_t)l * D * D; K = D; N = D; gain = norm_mem + l * D; scale = QS_MEM; WT = (bf16*)(ws + WS_MWQ) + (size_t)l * D * D; }
        else if ((rr -= 2 * I_SQ) < 2 * I_KV) { const int l = rr / I_KV; rr -= l * I_KV; W = (const float*)a.in[16] + (size_t)l * D * 2 * D; K = D; N = 2 * D; WT = (bf16*)(ws + WS_MWKV) + (size_t)l * 2 * D * D; }
        else if ((rr -= 2 * I_KV) < 2 * I_SQ) { const int l = rr / I_SQ; rr -= l * I_SQ; W = (const float*)a.in[17] + (size_t)l * D * D; K = D; N = D; WT = (bf16*)(ws + WS_MWO) + (size_t)l * D * D; }
        else if ((rr -= 2 * I_SQ) < 2 * I_GU) { const int l = rr / I_GU; rr -= l * I_GU; W = (const float*)a.in[18] + (size_t)l * D * 2 * DFF; K = D; N = 2 * DFF; gain = norm_ffn + l * D; WT = (bf16*)(ws + WS_WGU + l * WGU_BYTES); mode = 2; }
        else if ((rr -= 2 * I_GU) < 2 * I_DN) { const int l = rr / I_DN; rr -= l * I_DN; W = (const float*)a.in[19] + (size_t)l * DFF * D; K = DFF; N = D; WT = (bf16*)(ws + WS_WDN + l * WDN_BYTES); }
        else if ((rr -= 2 * I_DN) < I_KV) { W = (const float*)a.in[12]; K = D; N = 2 * D; gain = (const float*)a.in[11]; WT = (bf16*)(ws + WS_WKVQ); mode = 4; }
        else if ((rr -= I_KV) < I_SQ) { W = (const float*)a.in[13]; K = D; N = D; gain = norm_mix + D; scale = QS_MOBA; WT = (bf16*)(ws + WS_WKVQ) + (size_t)2 * D * D; mode = 3; }
        else { rr -= I_SQ; W = (const float*)a.in[14]; K = D; N = D; WT = (bf16*)(ws + WS_MOWO); }
        const int nblk = N / 64, kb = rr / nblk, nb = rr % nblk, n0 = nb * 64; int drow0 = n0;
        if (mode == 1) { if (n0 < D) drow0 = 2 * D + n0; else if (n0 < 2 * D) { const int ch = n0 - D; drow0 = (ch >> 7) * 256 + (ch & 127); } else { const int ch = n0 - 2 * D; drow0 = (ch >> 7) * 256 + 128 + (ch & 127); } }
        else if (mode == 2) { if (n0 < DFF) drow0 = (n0 >> 7) * 256 + (n0 & 127); else { const int ch = n0 - DFF; drow0 = (ch >> 7) * 256 + 128 + (ch & 127); } }
        transpose_item(W, K, N, gain, scale, WT, kb * 64, n0, drow0, lane, mode == 3 || (mode == 4 && n0 < D));
    }
    { const float* x = (const float*)a.in[0]; bf16* XB = (bf16*)(ws + WS_XB); float* SS = (float*)(ws + WS_SS);
      for (int mrow = gw; mrow < T; mrow += NGW) {
          const f32x4* xr = (const f32x4*)(x + (size_t)mrow * D) + lane; f32x4 v[4]; float s = 0.f;
#pragma unroll
          for (int j = 0; j < 4; ++j) { v[j] = __builtin_nontemporal_load(&xr[64 * j]); s += (v[j][0] * v[j][0] + v[j][1] * v[j][1]) + (v[j][2] * v[j][2] + v[j][3] * v[j][3]); }
          s = wave_sum(s);
          u32x2* o8 = (u32x2*)(XB + (size_t)mrow * D) + lane;
#pragma unroll
          for (int j = 0; j < 4; ++j) { u32x2 p; p.x = pg8::cvt_pk_bf16(v[j][0], v[j][1]); p.y = pg8::cvt_pk_bf16(v[j][2], v[j][3]); o8[64 * j] = p; }
          if (lane < 16) SS[(size_t)mrow * 16 + lane] = (lane == 0) ? s : 0.f;
      } }
    { const float* mem = (const float*)a.in[1];
      for (int it = gw; it < 2 * MEMT; it += NGW) {
          const int l = it / MEMT, mrow = it % MEMT; const float* gl = norm_memkv + l * D;
          const f32x4* xr = (const f32x4*)(mem + (size_t)mrow * D) + lane; f32x4 v[4]; float s = 0.f;
#pragma unroll
          for (int j = 0; j < 4; ++j) { v[j] = xr[64 * j]; s += (v[j][0] * v[j][0] + v[j][1] * v[j][1]) + (v[j][2] * v[j][2] + v[j][3] * v[j][3]); }
          const float rs = rsqrtf(wave_sum(s) * (1.0f / D) + pg8::RMS_EPS);
          u32x2* o8 = (u32x2*)((bf16*)(ws + WS_MEMN) + (size_t)l * MEMT * D + (size_t)mrow * D) + lane;
#pragma unroll
          for (int j = 0; j < 4; ++j) { const f32x4 gv = ((const f32x4*)gl)[lane + 64 * j]; u32x2 p; p.x = pg8::cvt_pk_bf16(v[j][0] * rs * gv[0], v[j][1] * rs * gv[1]); p.y = pg8::cvt_pk_bf16(v[j][2] * rs * gv[2], v[j][3] * rs * gv[3]); o8[64 * j] = p; }
      } }
    { const int* pos = (const int*)a.in[2]; float* rope = (float*)(ws + WS_ROPE);
      for (int e = c * NTHREADS + tid; e < T * 16; e += G * NTHREADS) {
          const int tkn = e >> 4, i = e & 15;
          const float inv_freq = exp2f(-(float)i * (18.931568569324174f / 16.0f));
          const float ang = (float)pos[tkn] * inv_freq;
          double rev = (double)ang * 0.15915494309189535; rev -= rint(rev);
          const float rf = (float)rev;
          rope[2 * e] = __builtin_amdgcn_cosf(rf); rope[2 * e + 1] = __builtin_amdgcn_sinf(rf);
      } }
}

__device__ __forceinline__ void conv_phase(const bf16* Z, const bf16* BG, bf16* OUT, const float* cw, int nb, int bid, int tid) {
    const int nitems = (T / 8) * 128;
    for (int item = bid * NTHREADS + tid; item < nitems; item += nb * NTHREADS) {
        const int tg = item >> 7, cc = item & 127, t0 = tg * 8, ch0 = cc * 8;
        float wv[3][8];
#pragma unroll
        for (int j = 0; j < 3; ++j) { const f32x4 a0 = *(const f32x4*)(cw + j * D + ch0), a1 = *(const f32x4*)(cw + j * D + ch0 + 4);
#pragma unroll
            for (int e = 0; e < 4; ++e) { wv[j][e] = a0[e]; wv[j][4 + e] = a1[e]; } }
        float z2[8], z1[8];
        const bool first = (t0 % SEQ) == 0;
        u32x4 r2 = (u32x4){0u, 0u, 0u, 0u}, r1 = r2;
        if (!first) { r2 = *(const u32x4*)(Z + (size_t)(t0 - 2) * D + ch0); r1 = *(const u32x4*)(Z + (size_t)(t0 - 1) * D + ch0); }
#pragma unroll
        for (int e = 0; e < 4; ++e) { z2[2 * e] = __builtin_bit_cast(float, r2[e] << 16); z2[2 * e + 1] = __builtin_bit_cast(float, r2[e] & 0xffff0000u);
                                      z1[2 * e] = __builtin_bit_cast(float, r1[e] << 16); z1[2 * e + 1] = __builtin_bit_cast(float, r1[e] & 0xffff0000u); }
#pragma unroll
        for (int i = 0; i < 8; ++i) {
            const size_t off = (size_t)(t0 + i) * D + ch0;
            const u32x4 rz = *(const u32x4*)(Z + off), rb = *(const u32x4*)(BG + off);
            float zc[8], bg[8], ov[8];
#pragma unroll
            for (int e = 0; e < 4; ++e) { zc[2 * e] = __builtin_bit_cast(float, rz[e] << 16); zc[2 * e + 1] = __builtin_bit_cast(float, rz[e] & 0xffff0000u);
                                          bg[2 * e] = __builtin_bit_cast(float, rb[e] << 16); bg[2 * e + 1] = __builtin_bit_cast(float, rb[e] & 0xffff0000u); }
#pragma unroll
            for (int e = 0; e < 8; ++e) { ov[e] = bg[e] * (wv[0][e] * z2[e] + wv[1][e] * z1[e] + wv[2][e] * zc[e]); z2[e] = z1[e]; z1[e] = zc[e]; }
            u32x4 w; w.x = pg8::cvt_pk_bf16(ov[0], ov[1]); w.y = pg8::cvt_pk_bf16(ov[2], ov[3]); w.z = pg8::cvt_pk_bf16(ov[4], ov[5]); w.w = pg8::cvt_pk_bf16(ov[6], ov[7]);
            __builtin_nontemporal_store(w, (u32x4*)(OUT + off));
        }
    }
}

__device__ __forceinline__ void final_phase(const bf16* XBp, float* OUT, const float* SS, const float* gfin, int G, int c, int tid) {
    const int lane = tid & 63, w = tid >> 6, gw = c * NWAVES + w, NGW = G * NWAVES;
    for (int mrow = gw; mrow < T; mrow += NGW) {
        float s = (lane < 16) ? SS[(size_t)mrow * 16 + lane] : 0.f;
        s = wave_sum(s);
        const float rs = rsqrtf(s * (1.0f / D) + pg8::RMS_EPS);
        const u32x4* xr = (const u32x4*)(XBp + (size_t)mrow * D) + lane; f32x4* orow = (f32x4*)(OUT + (size_t)mrow * D) + 2 * lane;
#pragma unroll
        for (int j = 0; j < 2; ++j) {
            const u32x4 b = __builtin_nontemporal_load(&xr[64 * j]); const f32x4 g0 = ((const f32x4*)gfin)[2 * lane + 128 * j], g1 = ((const f32x4*)gfin)[2 * lane + 128 * j + 1];
            f32x4 v0, v1;
            v0[0] = __builtin_bit_cast(float, b.x << 16); v0[1] = __builtin_bit_cast(float, b.x & 0xffff0000u); v0[2] = __builtin_bit_cast(float, b.y << 16); v0[3] = __builtin_bit_cast(float, b.y & 0xffff0000u);
            v1[0] = __builtin_bit_cast(float, b.z << 16); v1[1] = __builtin_bit_cast(float, b.z & 0xffff0000u); v1[2] = __builtin_bit_cast(float, b.w << 16); v1[3] = __builtin_bit_cast(float, b.w & 0xffff0000u);
            __builtin_nontemporal_store(v0 * rs * g0, &orow[128 * j]); __builtin_nontemporal_store(v1 * rs * g1, &orow[128 * j + 1]);
        }
    }
}

#define XB_TMO      128
#define XB_XCNT(j)  (256  + 64 * (j))
#define XB_XSUB(j)  (1280 + 64 * (j))
#define XB_XGEN(j)  (2304 + 64 * (j))
#define XB_TOP      3328
#define XB_TOPGEN   3392
#define XCD_BAR_WORDS 3456
#define XB_SPIN_CAP (1u << 18)

__device__ __forceinline__ unsigned xb_ld(unsigned* p)              { return __hip_atomic_load(p, __ATOMIC_RELAXED, __HIP_MEMORY_SCOPE_AGENT); }
__device__ __forceinline__ unsigned xb_add(unsigned* p, unsigned v) { return __hip_atomic_fetch_add(p, v, __ATOMIC_RELAXED, __HIP_MEMORY_SCOPE_AGENT); }
__device__ __forceinline__ unsigned xb_xcc_id() { return (unsigned)__builtin_amdgcn_s_getreg((3 << 11) | 20) & 0xFu; }
#define XB_SPIN(cond, bar) do { unsigned _sp = 0; while (cond) { __builtin_amdgcn_s_sleep(1); \
    if ((++_sp & 255u) == 0u) { if (xb_ld(&(bar)[XB_TMO])) break; if (_sp > XB_SPIN_CAP) { atomicAdd(&(bar)[XB_TMO], 1u); break; } } } } while (0)

struct XcdBarrier {
    unsigned* bar; unsigned x;
    volatile LAS unsigned* st;
};

__device__ __forceinline__ XcdBarrier xcd_barrier_post(unsigned* bar, volatile LAS unsigned* st) {
    XcdBarrier b; b.bar = bar; b.x = xb_xcc_id(); b.st = st;
    if (threadIdx.x == 0) (void)xb_add(&bar[XB_XCNT(b.x)], 1u);
    return b;
}
__device__ __forceinline__ void xcd_barrier_complete(unsigned* bar, unsigned x, unsigned& nloc, unsigned& nx) {
    const unsigned G = gridDim.x * gridDim.y * gridDim.z;
    unsigned sum, cnt, mine, sp = 0u;
    for (;;) {
        sum = 0u; cnt = 0u; mine = 0u;
#pragma unroll
        for (unsigned j = 0; j < 16; ++j) { const unsigned c = xb_ld(&bar[XB_XCNT(j)]); sum += c; cnt += (c > 0u) ? 1u : 0u; mine = (j == x) ? c : mine; }
        if (sum == G) break;
        __builtin_amdgcn_s_sleep(1);
        if ((++sp & 255u) == 0u) { if (xb_ld(&bar[XB_TMO])) break; if (sp > XB_SPIN_CAP) { atomicAdd(&bar[XB_TMO], 1u); break; } }
    }
    nloc = mine > 0u ? mine : 1u; nx = cnt > 0u ? cnt : 1u;
}

__device__ __forceinline__ void xcd_barrier(const XcdBarrier& b) {
    asm volatile("s_waitcnt vmcnt(0)" ::: "memory");
    __syncthreads();
    if (threadIdx.x == 0) {
        unsigned* bar = b.bar;
        __builtin_amdgcn_s_waitcnt(0);
        unsigned nloc = b.st[0], nx = b.st[1];
        if (nloc == 0u) { xcd_barrier_complete(bar, b.x, nloc, nx); b.st[0] = nloc; b.st[1] = nx; }
        const unsigned old = xb_add(&bar[XB_XSUB(b.x)], 1u);
        const unsigned gen = old / nloc;
        if (old + 1u == (gen + 1u) * nloc) {
            __builtin_amdgcn_fence(__ATOMIC_RELEASE, "agent");
            asm volatile("s_waitcnt vmcnt(0)" ::: "memory");
            const unsigned og = xb_add(&bar[XB_TOP], 1u);
            const unsigned tg = og / nx;
            if (og + 1u == (tg + 1u) * nx) xb_add(&bar[XB_TOPGEN], 1u);
            else XB_SPIN(xb_ld(&bar[XB_TOPGEN]) == tg, bar);
            __builtin_amdgcn_fence(__ATOMIC_ACQUIRE, "agent");
            xb_add(&bar[XB_XGEN(b.x)], 1u);
            asm volatile("s_waitcnt vmcnt(0)" ::: "memory");
        } else {
            XB_SPIN(xb_ld(&bar[XB_XGEN(b.x)]) == gen, bar);
            __builtin_amdgcn_fence(__ATOMIC_ACQUIRE, "agent");
            asm volatile("s_waitcnt vmcnt(0)" ::: "memory");
        }
    }
    __syncthreads();
}

constexpr int NPHASES = 18;
__global__ void __launch_bounds__(NTHREADS, 2) mega_fwd(Args a) {
    extern __shared__ __attribute__((aligned(16))) unsigned char lds_raw[];
    LAS unsigned char* lds = (LAS unsigned char*)lds_raw;
    cg::grid_group grid = cg::this_grid();
    const int G = gridDim.x, bx = blockIdx.x;
    const int vcu = (G % 8 == 0) ? (bx % 8) * (G / 8) + bx / 8 : bx;
    unsigned char* ws = a.ws;
    bf16* const XB = (bf16*)(ws + WS_XB);
    bf16* const R0 = (bf16*)(ws + WS_R0); bf16* const R1 = (bf16*)(ws + WS_R1); bf16* const R2 = (bf16*)(ws + WS_R2);
    float* const SS = (float*)(ws + WS_SS);
    float* const KMP = (float*)(ws + WS_KMP);
    const float* const ROPE = (const float*)(ws + WS_ROPE);
    float* const X = a.out;
    volatile LAS unsigned* const MISC = (volatile LAS unsigned*)(lds + 131072);
    if (threadIdx.x < 64) MISC[threadIdx.x] = 0u;
    unsigned* const barw = (unsigned*)(ws + WS_BAR);
    if (bx == 0) for (int i = threadIdx.x; i < XCD_BAR_WORDS; i += NTHREADS) __hip_atomic_store(barw + i, 0u, __ATOMIC_RELAXED, __HIP_MEMORY_SCOPE_AGENT);
    __syncthreads();
    grid.sync();
    XcdBarrier xb = xcd_barrier_post(barw, MISC + 8);

    for (int ph = a.ph_lo; ph < a.ph_hi; ++ph) {
#ifndef PROBE_DUP_MASK
#define PROBE_DUP_MASK 0
#endif
#ifndef PROBE_EXTRA_SYNCS
#define PROBE_EXTRA_SYNCS 0
#endif
        const int nrep = ((PROBE_DUP_MASK >> ph) & 1) ? 2 : 1;
        for (int rep = 0; rep < nrep; ++rep) {
        int tid = threadIdx.x; asm volatile("" : "+v"(tid));
        int kind = 0; pg8::Gemm g{nullptr, nullptr, 0, 0, 0}; int sG = G, sc = bx;
        pg8::EpiBf16X e1{nullptr, 0, 0, 0, nullptr, nullptr, 0u, nullptr};
        pg8::EpiSwiGLU e3{nullptr, DFF, SS};
        pg8::EpiRes e4{XB, XB, SS};
        const int l = (ph >= 10) ? 1 : 0;
        switch (ph) {
        case 0:
#ifndef NO_PRO
            prologue(a, (LAS char*)lds, G, vcu, tid);
#endif
            break;
        case 1: kind = 2; g = pg8::Gemm{XB, (const bf16*)(ws + WS_WIN), T, 3 * D, D}; break;
        case 2:
            {
                if (bx < 64) { const int ll = bx >> 5; kind = 1; g = pg8::Gemm{(const bf16*)(ws + WS_MEMN) + (size_t)ll * MEMT * D, (const bf16*)(ws + WS_MWKV) + (size_t)ll * 2 * D * D, MEMT, 2 * D, D}; sG = 32; sc = bx & 31;
                    e1.O = (bf16*)(ws + WS_KVM) + (size_t)ll * MEMT * 2 * D; e1.ldc = 2 * D; }
            }
#ifndef NO_CONV
            if (bx >= 64) conv_phase(R0, R1, (nrep == 2 && rep == 0) ? R2 : R1, (const float*)a.in[9], G - 64, bx - 64, tid);
#endif
            break;
        case 3: kind = 4; g = pg8::Gemm{R1, (const bf16*)(ws + WS_WOUT), T, D, D}; break;
        case 4: case 12: kind = 1; g = pg8::Gemm{XB, (const bf16*)(ws + WS_MWQ) + (size_t)l * D * D, T, D, D}; e1.O = R0; e1.ldc = D; e1.ss = SS; break;
        case 5: case 13:
#ifndef NO_MEM
            { asm volatile("s_waitcnt vmcnt(0)" ::: "memory"); __syncthreads();
              pg8::StaticOrder Sm; Sm.init(T, D, G, bx);
              memattn_phase((LAS char*)lds, R0, (const bf16*)(ws + WS_KVM) + (size_t)l * MEMT * 2 * D, R1, Sm, tid); }
#endif
            break;
        case 6: case 14: kind = 4; g = pg8::Gemm{R1, (const bf16*)(ws + WS_MWO) + (size_t)l * D * D, T, D, D}; break;
        case 7: case 15: kind = 3; g = pg8::Gemm{XB, (const bf16*)(ws + WS_WGU + l * WGU_BYTES), T, 2 * DFF, D}; e3.ACT = R0; break;
        case 8: case 16: kind = 4; g = pg8::Gemm{R0, (const bf16*)(ws + WS_WDN + l * WDN_BYTES), T, D, DFF};
            if (nrep == 2 && rep == 0) { e4.xb = (bf16*)(ws + WS_END); e4.ss = (float*)(ws + WS_END + 32 * MiB); }
            break;
        case 9: kind = 1; g = pg8::Gemm{XB, (const bf16*)(ws + WS_WKVQ), T, 3 * D, D}; e1.O = R0; e1.ldc = D; e1.split_cols = D; e1.split_stride = (size_t)T * D; e1.ss = SS; e1.rope = ROPE; e1.rope_mask = 5u; e1.kmp = KMP; break;
        case 10:
#ifndef NO_MOBA
            #ifdef PROBE_VARIANTS
            if (!(PROBE_VARIANTS == 6 && nrep == 2 && rep == 0))
            moba_phase((LAS char*)lds, R2, R0, R1, (nrep == 2 && rep == 0) ? (bf16*)(ws + WS_END) : R2, KMP, G, vcu, tid, (nrep == 2 && rep == 0) ? PROBE_VARIANTS : 0);
#else
            moba_phase((LAS char*)lds, R2, R0, R1, (nrep == 2 && rep == 0) ? (bf16*)(ws + WS_END) : R2, KMP, G, vcu, tid);
#endif
#endif
            break;
        case 11: kind = 4; g = pg8::Gemm{R2, (const bf16*)(ws + WS_MOWO), T, D, D}; break;
        case 17:
#ifndef NO_FIN
            final_phase(XB, (nrep == 2 && rep == 0) ? (float*)R0 : X, SS, (const float*)a.in[7], G, vcu, tid);
#endif
            break;
        default: break;
        }
        if (kind) {
            pg8::StaticOrder S; S.init(g.M, g.N, sG, sc);
#ifndef NO_G1
            if (kind == 1) pg8::gemm_phase<pg8::EpiBf16X, pg8::StaticOrder, true, true>(lds, g, S, e1, tid);
#endif
#ifndef NO_G2
            if (kind == 2) { pg8::EpiMul e2{R0, R1, SS}; pg8::gemm_phase<pg8::EpiMul, pg8::StaticOrder, true, true>(lds, g, S, e2, tid); }
#endif
#ifndef NO_G3
            if (kind == 3) pg8::gemm_phase<pg8::EpiSwiGLU, pg8::StaticOrder, true, true>(lds, g, S, e3, tid);
#endif
#ifndef NO_G4
            if (kind == 4) pg8::gemm_phase<pg8::EpiRes, pg8::StaticOrder, true, true>(lds, g, S, e4, tid);
#endif
        }
        if (rep + 1 < nrep) xcd_barrier(xb);
        }
        if (ph == 1) for (int e = 0; e < PROBE_EXTRA_SYNCS; ++e) xcd_barrier(xb);
        if (ph + 1 < a.ph_hi && ph != 4 && ph != 12) {
            xcd_barrier(xb);
        }
    }
}

#ifndef MK_ONE_LAUNCH
#define MK_ONE_LAUNCH 1
#endif
extern "C" void kernel_launch(void* const* d_in, const int* in_sizes, int n_in, void* d_out, int out_size, void* d_ws, size_t ws_size, hipStream_t stream) {
    static int grid = 0;
    if (grid == 0) {
        if (n_in != 20 || out_size != T * D || ws_size < WS_END) { fprintf(stderr, "kernel_launch: unexpected shapes (n_in %d out %d ws %zu)\n", n_in, out_size, ws_size); grid = -1; return; }
        int dev = 0, cus = 0, per_cu = 0;
        hipGetDevice(&dev); hipDeviceGetAttribute(&cus, hipDeviceAttributeMultiprocessorCount, dev);
        hipFuncSetAttribute((const void*)mega_fwd, hipFuncAttributeMaxDynamicSharedMemorySize, LDS_BYTES);
        hipOccupancyMaxActiveBlocksPerMultiprocessor(&per_cu, (const void*)mega_fwd, NTHREADS, LDS_BYTES);
        if (per_cu < 1) { fprintf(stderr, "kernel_launch: occupancy query says %d blocks per CU\n", per_cu); per_cu = 1; }
        if (per_cu > 1) per_cu = 1;
        grid = cus * per_cu;
    }
    if (grid < 0) return;
    Args a{};
    for (int i = 0; i < 20; ++i) a.in[i] = d_in[i];
    a.out = (float*)d_out; a.ws = (unsigned char*)d_ws;
#if MK_ONE_LAUNCH
    a.ph_lo = 0; a.ph_hi = NPHASES;
    void* args[] = {&a};
    hipError_t e = hipLaunchCooperativeKernel((const void*)mega_fwd, dim3(grid), dim3(NTHREADS), args, LDS_BYTES, stream);
    if (e != hipSuccess) fprintf(stderr, "cooperative launch failed: %s (grid %d)\n", hipGetErrorString(e), grid);
#else
    for (int ph = 0; ph < NPHASES; ++ph) {
        a.ph_lo = ph; a.ph_hi = ph + 1;
        hipLaunchKernelGGL(mega_fwd, dim3(grid), dim3(NTHREADS), LDS_BYTES, stream, a);
    }
#endif
}
```

```cpp
#include <hip/hip_runtime.h>
#include <hip/hip_cooperative_groups.h>
#include <cstdio>
#include <cstdint>
namespace cg = cooperative_groups;
namespace pg8 {
#define PG8_LAS __attribute__((address_space(3)))
typedef unsigned short bf16_t;
typedef short bf16x8 __attribute__((ext_vector_type(8)));
typedef float f32x4 __attribute__((ext_vector_type(4)));
typedef unsigned u32x4 __attribute__((ext_vector_type(4)));
constexpr int BM = 256, BK = 64, HALF = 128, HTB = HALF * BK * 2  , STAGE_BYTES = 8 * HTB, NXCD = 8, WGM = 2;

__host__ __device__ __forceinline__ int lds_byte(int r, int c) { const int st = (r >> 4) * 2 + (c >> 5), rr = r & 15, cc = c & 31, ob = rr * 64 + cc * 2; return st * 1024 + (ob ^ (((ob >> 9) & 1) << 5)); }
__host__ __device__ __forceinline__ void stage_rc(int b, int& R, int& C) { const int st = b / 1024, sb = b % 1024, swz = sb ^ (((sb >> 9) & 1) << 5); R = (st >> 1) * 16 + swz / 64; C = (st & 1) * 32 + (swz % 64) / 2; }
__host__ __device__ __forceinline__ int perm32(int rho) { const int n = rho >> 4, i = rho & 15; return 8 * (i >> 2) + 4 * n + (i & 3); }

struct Unit { int pm, pn, roff, half; };
struct Gemm { const bf16_t* A; const bf16_t* Bt; int M, N, K; };

struct StaticOrder {
    int nM, nN, nwg, G, c, hs;
    __host__ __device__ void init(int M, int N, int G_, int c_) { nM = M / BM; nN = N / BM; nwg = nM * nN; G = G_; c = c_; hs = (2 * (nwg % G) == G) ? 1 : 0; }
    __host__ __device__ bool next(int i, Unit& u) const {
        long L = (long)i * G + c; u.roff = 0; u.half = 0;
        if (hs) { const int nfr = nwg / G; if (i > nfr) return false; if (i == nfr) { L = (long)nfr * G + (c >> 1); u.roff = c & 1; u.half = 1; } }
        if (L >= nwg) return false;
        int wgid = (int)L; { const int q = nwg / NXCD, r = nwg % NXCD, xcd = wgid % NXCD, off = wgid / NXCD; wgid = (xcd < r ? xcd * (q + 1) : r * (q + 1) + (xcd - r) * q) + off; }
        const int nig = WGM * nN, gid = wgid / nig, fm = gid * WGM, gsz = (nM - fm) < WGM ? (nM - fm) : WGM;
        u.pm = fm + ((wgid % nig) % gsz); u.pn = (wgid % nig) / gsz; return true;
    }
    __device__ __forceinline__ void a_ready(const Unit&) const {}
    __device__ __forceinline__ void done(const Unit&) const {}
};


__device__ __forceinline__ unsigned cvt_pk_bf16(float lo, float hi) {
    typedef float f2_t __attribute__((ext_vector_type(2))); typedef __bf16 b2_t __attribute__((ext_vector_type(2)));
    f2_t v = {lo, hi}; b2_t b = __builtin_convertvector(v, b2_t); return __builtin_bit_cast(unsigned, b); }
__device__ __forceinline__ u32x4 pack8(const f32x4 v0, const f32x4 v1) { u32x4 w; w.x = cvt_pk_bf16(v0[0], v0[1]); w.y = cvt_pk_bf16(v0[2], v0[3]); w.z = cvt_pk_bf16(v1[0], v1[1]); w.w = cvt_pk_bf16(v1[2], v1[3]); return w; }
constexpr float RMS_EPS = 1e-6f;
__device__ __forceinline__ float row_rstd(const float* ss, int row, int fq) {
    const f32x4 v = *(const f32x4*)(ss + (size_t)row * 16 + 4 * fq);
    float s = (v[0] + v[1]) + (v[2] + v[3]);
    {
        const unsigned u0 = __builtin_bit_cast(unsigned, s); const auto r16 = __builtin_amdgcn_permlane16_swap(u0, u0, false, false);
        s = __builtin_bit_cast(float, (unsigned)r16[0]) + __builtin_bit_cast(float, (unsigned)r16[1]);
        const unsigned u1 = __builtin_bit_cast(unsigned, s); const auto r32 = __builtin_amdgcn_permlane32_swap(u1, u1, false, false);
        s = __builtin_bit_cast(float, (unsigned)r32[0]) + __builtin_bit_cast(float, (unsigned)r32[1]);
    }
    return rsqrtf(s * (1.0f / 1024.0f) + RMS_EPS);
}

struct EpiBf16X {
    static constexpr bool PERM = true, AFTER_DRAIN = false;
    bf16_t* O; int ldc; int split_cols; size_t split_stride;
    const float* ss; const float* rope; unsigned rope_mask; float* kmp;
    __device__ __forceinline__ void operator()(const f32x4 (&acc)[2][2][4][2], const Unit& u, int wr, int wc, int fr, int fq) const {
        const int row0 = u.pm * BM + wr * 64 + fr; int colt = u.pn * BM; bf16_t* base = O; int t = 0;
        if (split_cols) { t = colt / split_cols; base += (size_t)t * split_stride; colt -= t * split_cols; }
        const int col0 = colt + wc * 32 + 8 * fq;
        const bool do_rope = (rope != nullptr) && ((rope_mask >> t) & 1u);
        const bool do_km = (kmp != nullptr) && (t == 0);
        f32x4 ks[2][2];
#pragma unroll
        for (int bj = 0; bj < 2; ++bj)
#pragma unroll
            for (int n = 0; n < 2; ++n) ks[bj][n] = (f32x4){0.f, 0.f, 0.f, 0.f};
#pragma unroll
        for (int ai = 0; ai < 2; ++ai)
#pragma unroll
            for (int m = 0; m < 4; ++m) {
                const int row = row0 + ai * HALF + m * 16;
                const float rs = ss ? row_rstd(ss, row, fq) : 1.0f;
                f32x4 v[2][2];
#pragma unroll
                for (int bj = 0; bj < 2; ++bj)
#pragma unroll
                    for (int n = 0; n < 2; ++n) v[bj][n] = acc[ai][bj][m][n] * rs;
                if (do_rope && fq == 0) {
                    const float* cp = rope + (size_t)row * 32 + 8 * wc;
                    const f32x4 c0 = *(const f32x4*)(cp), c1 = *(const f32x4*)(cp + 4);
                    const float cs[8] = {c0[0], c0[1], c0[2], c0[3], c1[0], c1[1], c1[2], c1[3]};
#pragma unroll
                    for (int bj = 0; bj < 2; ++bj)
#pragma unroll
                        for (int j = 0; j < 4; ++j) { const float x1 = v[bj][0][j], x2 = v[bj][1][j], c = cs[2 * j], sn = cs[2 * j + 1];
                            v[bj][0][j] = x1 * c - x2 * sn; v[bj][1][j] = x2 * c + x1 * sn; }
                }
                if (do_km) {
#pragma unroll
                    for (int bj = 0; bj < 2; ++bj)
#pragma unroll
                        for (int n = 0; n < 2; ++n) ks[bj][n] += v[bj][n];
                }
                bf16_t* rowp = base + (size_t)row * ldc + col0;
#pragma unroll
                for (int bj = 0; bj < 2; ++bj) *(u32x4*)(rowp + bj * HALF) = pack8(v[bj][0], v[bj][1]);
            }
        if (do_km) {
#pragma unroll
            for (int bj = 0; bj < 2; ++bj)
#pragma unroll
                for (int n = 0; n < 2; ++n)
#pragma unroll
                    for (int j = 0; j < 4; ++j) { float s = ks[bj][n][j]; s += __shfl_xor(s, 1); s += __shfl_xor(s, 2); s += __shfl_xor(s, 4); s += __shfl_xor(s, 8); ks[bj][n][j] = s; }
            if (fr == 0) { float* kp = kmp + ((size_t)u.pm * 2 + wr) * 1024 + col0;
#pragma unroll
                for (int bj = 0; bj < 2; ++bj)
#pragma unroll
                    for (int n = 0; n < 2; ++n) *(f32x4*)(kp + bj * HALF + 4 * n) = ks[bj][n]; }
        }
    }
};

struct EpiMul {
    static constexpr bool PERM = true, AFTER_DRAIN = false;
    bf16_t* Z; bf16_t* BG; const float* ss;
    __device__ __forceinline__ void operator()(const f32x4 (&acc)[2][2][4][2], const Unit& u, int wr, int wc, int fr, int fq) const {
        const int row0 = u.pm * BM + wr * 64 + fr;
#pragma unroll
        for (int ai = 0; ai < 2; ++ai)
#pragma unroll
            for (int m = 0; m < 4; ++m) {
                const int row = row0 + ai * HALF + m * 16;
                const float rs = row_rstd(ss, row, fq);
                if (u.pn < 8) {
                    const float r2 = rs * rs;
                    const f32x4 z0 = acc[ai][0][m][0] * acc[ai][1][m][0] * r2, z1 = acc[ai][0][m][1] * acc[ai][1][m][1] * r2;
                    __builtin_nontemporal_store(pack8(z0, z1), (u32x4*)(Z + (size_t)row * 1024 + u.pn * 128 + wc * 32 + 8 * fq));
                } else {
                    bf16_t* rowp = BG + (size_t)row * 1024 + (u.pn - 8) * 256 + wc * 32 + 8 * fq;
#pragma unroll
                    for (int bj = 0; bj < 2; ++bj) __builtin_nontemporal_store(pack8(acc[ai][bj][m][0] * rs, acc[ai][bj][m][1] * rs), (u32x4*)(rowp + bj * HALF));
                }
            }
    }
};

struct EpiSwiGLU {
    static constexpr bool PERM = true, AFTER_DRAIN = false;
    bf16_t* ACT; int ldc; const float* ss;
    __device__ __forceinline__ void operator()(const f32x4 (&acc)[2][2][4][2], const Unit& u, int wr, int wc, int fr, int fq) const {
        const int row0 = u.pm * BM + u.roff * HALF + wr * 64 + fr;
#pragma unroll
        for (int ai = 0; ai < 2; ++ai)
          if (ai == 0 || !u.half)
#pragma unroll
            for (int m = 0; m < 4; ++m) {
                const int row = row0 + ai * HALF + m * 16;
                const float rs = row_rstd(ss, row, fq);
                f32x4 o[2];
#pragma unroll
                for (int n = 0; n < 2; ++n)
#pragma unroll
                    for (int j = 0; j < 4; ++j) { const float g = acc[ai][0][m][n][j] * rs, uu = acc[ai][1][m][n][j] * rs;
                        const float sg = g * __builtin_amdgcn_rcpf(1.0f + __builtin_amdgcn_exp2f(-1.4426950408889634f * g)); o[n][j] = sg * uu; }
                __builtin_nontemporal_store(pack8(o[0], o[1]), (u32x4*)(ACT + (size_t)row * ldc + u.pn * 128 + wc * 32 + 8 * fq));
            }
    }
};

struct EpiRes {
    static constexpr bool PERM = true, AFTER_DRAIN = false;
    const bf16_t* base; bf16_t* xb; float* ss;
    __device__ __forceinline__ void operator()(const f32x4 (&acc)[2][2][4][2], const Unit& u, int wr, int wc, int fr, int fq) const {
        const int row0 = u.pm * BM + wr * 64 + fr; const int col0 = u.pn * BM + wc * 32 + 8 * fq;
#pragma unroll
        for (int ai = 0; ai < 2; ++ai) {
            u32x4 bv[4][2];
#pragma unroll
            for (int m = 0; m < 4; ++m)
#pragma unroll
                for (int bj = 0; bj < 2; ++bj) bv[m][bj] = *(const u32x4*)(base + (size_t)(row0 + ai * HALF + m * 16) * 1024 + col0 + bj * HALF);
#pragma unroll
            for (int m = 0; m < 4; ++m) {
                const int row = row0 + ai * HALF + m * 16; const size_t off = (size_t)row * 1024 + col0; float sq = 0.f;
#pragma unroll
                for (int bj = 0; bj < 2; ++bj) {
                    const u32x4 b = bv[m][bj];
                    f32x4 b0, b1;
                    b0[0] = __builtin_bit_cast(float, b.x << 16); b0[1] = __builtin_bit_cast(float, b.x & 0xffff0000u); b0[2] = __builtin_bit_cast(float, b.y << 16); b0[3] = __builtin_bit_cast(float, b.y & 0xffff0000u);
                    b1[0] = __builtin_bit_cast(float, b.z << 16); b1[1] = __builtin_bit_cast(float, b.z & 0xffff0000u); b1[2] = __builtin_bit_cast(float, b.w << 16); b1[3] = __builtin_bit_cast(float, b.w & 0xffff0000u);
                    const f32x4 v0 = acc[ai][bj][m][0] + b0, v1 = acc[ai][bj][m][1] + b1;
                    *(u32x4*)(xb + off + bj * HALF) = pack8(v0, v1);
                    sq += (v0[0] * v0[0] + v0[1] * v0[1]) + (v0[2] * v0[2] + v0[3] * v0[3]) + (v1[0] * v1[0] + v1[1] * v1[1]) + (v1[2] * v1[2] + v1[3] * v1[3]);
                }
                sq += __shfl_xor(sq, 16); sq += __shfl_xor(sq, 32);
                if (fq == 0) ss[(size_t)row * 16 + u.pn * 4 + wc] = sq;
            }
        }
    }
};

template <class Epi, class Sched, bool ALIGN_EPI = false, bool SP2 = false>
__device__ __forceinline__ void gemm_phase(PG8_LAS unsigned char* lds, const Gemm g, const Sched& S, const Epi& E, const int tid) {
    const int  wid = __builtin_amdgcn_readfirstlane(tid >> 6), lane = tid & 63, wr = wid >> 2, wc = wid & 3, fr = lane & 15, fq = lane >> 4;
    const int K = g.K, nt = K / BK;
    unsigned voffA[2], voffB[2];
#pragma unroll
    for (int i = 0; i < 2; ++i) { int R, C; stage_rc(tid * 16 + i * 8192, R, C); const int Rb = Epi::PERM ? ((R & ~31) + perm32(R & 31)) : R;
        voffA[i] = (unsigned)(R * K + C) * 2u; voffB[i] = (unsigned)(Rb * K + C) * 2u; }
    const size_t kstep = (size_t)(BK * 2);
    const size_t hstep = (size_t)HALF * K * 2;
    const size_t tstep = 2 * hstep;
    const unsigned ldsw = (unsigned)wid * 1024u;
    const int aoff = lds_byte(wr * 64 + fr, fq * 8), boff = lds_byte(wc * 32 + fr, fq * 8);
#define PG8_SA(b, h) (((b) * 2 + (h)) * HTB)
#define PG8_SB(b, h) ((4 + (b) * 2 + (h)) * HTB)
#define PG8_STAGE(bufoff, gbase, voff) do { _Pragma("unroll") for (int _i = 0; _i < 2; ++_i) \
        __builtin_amdgcn_global_load_lds((const unsigned*)((const char*)(gbase) + (voff)[_i]), (PG8_LAS unsigned*)(lds + (bufoff) + ldsw + _i * 8192), 16, 0, 0); } while (0)
#define PG8_LDA(dst, b, h) do { _Pragma("unroll") for (int m = 0; m < 4; ++m) _Pragma("unroll") for (int k = 0; k < 2; ++k) dst[m][k] = *(const PG8_LAS bf16x8*)(lds + PG8_SA(b, h) + aoff + m * 2048 + k * 1024); } while (0)
#define PG8_LDB(dst, b, h) do { _Pragma("unroll") for (int n = 0; n < 2; ++n) _Pragma("unroll") for (int k = 0; k < 2; ++k) dst[n][k] = *(const PG8_LAS bf16x8*)(lds + PG8_SB(b, h) + boff + n * 2048 + k * 1024); } while (0)
#define PG8_MMA(ai, bj, At, Bt) do { __builtin_amdgcn_s_setprio(1); _Pragma("unroll") for (int m = 0; m < 4; ++m) _Pragma("unroll") for (int n = 0; n < 2; ++n) _Pragma("unroll") for (int k = 0; k < 2; ++k) \
        acc[ai][bj][m][n] = __builtin_amdgcn_mfma_f32_16x16x32_bf16(Bt[n][k], At[m][k], acc[ai][bj][m][n], 0, 0, 0); __builtin_amdgcn_s_setprio(0); } while (0)
#define PG8_WAIT_V(n) asm volatile("s_waitcnt vmcnt(" #n ")" ::: "memory")
#define PG8_WAIT_L(n) asm volatile("s_waitcnt lgkmcnt(" #n ")" ::: "memory")
#define PG8_BAR __builtin_amdgcn_s_barrier()
#define PG8_SCHED __builtin_amdgcn_sched_barrier(0)
    Unit cur, nxt; int ui = 0;
    if (!S.next(0, cur)) return;
    f32x4 acc[2][2][4][2];
#pragma unroll
    for (int a = 0; a < 2; ++a)
#pragma unroll
        for (int b = 0; b < 2; ++b)
#pragma unroll
            for (int m = 0; m < 4; ++m)
#pragma unroll
                for (int n = 0; n < 2; ++n) acc[a][b][m][n] = (f32x4){0.f, 0.f, 0.f, 0.f};
    bf16x8 At[4][2], B0[2][2], B1[2][2];
    const char* cA = (const char*)g.A + (size_t)cur.pm * tstep + (size_t)cur.roff * hstep; const char* cB = (const char*)g.Bt + (size_t)cur.pn * tstep;
    S.a_ready(cur);
    if constexpr (SP2) {
        PG8_STAGE(PG8_SB(0, 0), cB, voffB); PG8_STAGE(PG8_SB(0, 1), cB + hstep, voffB); PG8_STAGE(PG8_SA(0, 0), cA, voffA); PG8_STAGE(PG8_SA(0, 1), cA + hstep, voffA);
        if (wr == 1) PG8_BAR;
        PG8_WAIT_V(2); PG8_BAR;
        PG8_STAGE(PG8_SB(1, 0), cB + kstep, voffB); PG8_STAGE(PG8_SA(1, 0), cA + kstep, voffA); PG8_STAGE(PG8_SB(1, 1), cB + hstep + kstep, voffB);
        PG8_WAIT_V(6); PG8_BAR;
    } else {
        PG8_STAGE(PG8_SB(0, 0), cB, voffB); PG8_STAGE(PG8_SA(0, 0), cA, voffA); PG8_STAGE(PG8_SB(0, 1), cB + hstep, voffB); PG8_STAGE(PG8_SA(0, 1), cA + hstep, voffA);
        if (wr == 1) PG8_BAR;
        PG8_WAIT_V(4); PG8_BAR;
        PG8_STAGE(PG8_SB(1, 0), cB + kstep, voffB); PG8_STAGE(PG8_SA(1, 0), cA + kstep, voffA); PG8_STAGE(PG8_SB(1, 1), cB + hstep + kstep, voffB);
        PG8_WAIT_V(6); PG8_BAR;
    }
    for (;;) {
        const bool has_next = S.next(ui + 1, nxt);
        const char* nA = has_next ? (const char*)g.A + (size_t)nxt.pm * tstep + (size_t)nxt.roff * hstep : cA; const char* nB = has_next ? (const char*)g.Bt + (size_t)nxt.pn * tstep : cB;
        for (int t = 0; t < nt; t += 2) {
            const bool last = (t == nt - 2);
            const char* a1 = cA + (size_t)(t + 1) * kstep;
            const char* a2 = last ? nA : cA + (size_t)(t + 2) * kstep; const char* b2 = last ? nB : cB + (size_t)(t + 2) * kstep;
            const char* a3 = a2 + kstep; const char* b3 = b2 + kstep;
            if (last && has_next) S.a_ready(nxt);
            if constexpr (SP2) {
            PG8_LDB(B0, 0, 0); PG8_LDB(B1, 0, 1); PG8_SCHED; PG8_LDA(At, 0, 0); PG8_STAGE(PG8_SA(1, 1), a1 + hstep, voffA);
            PG8_WAIT_V(8); PG8_WAIT_L(0); PG8_BAR; PG8_MMA(0, 0, At, B0); PG8_MMA(0, 1, At, B1); PG8_BAR; PG8_SCHED;
            PG8_LDA(At, 0, 1); PG8_STAGE(PG8_SB(0, 0), b2, voffB); PG8_STAGE(PG8_SB(0, 1), b2 + hstep, voffB); PG8_STAGE(PG8_SA(0, 0), a2, voffA);
            PG8_WAIT_V(8); PG8_WAIT_L(0); PG8_BAR; if (!cur.half) { PG8_MMA(1, 0, At, B0); PG8_MMA(1, 1, At, B1); } PG8_BAR; PG8_SCHED;
            PG8_LDB(B0, 1, 0); PG8_LDB(B1, 1, 1); PG8_SCHED; PG8_LDA(At, 1, 0); PG8_STAGE(PG8_SA(0, 1), a2 + hstep, voffA);
            PG8_WAIT_V(8); PG8_WAIT_L(0); PG8_BAR; PG8_MMA(0, 0, At, B0); PG8_MMA(0, 1, At, B1); PG8_BAR; PG8_SCHED;
            PG8_LDA(At, 1, 1); PG8_STAGE(PG8_SB(1, 0), b3, voffB); PG8_STAGE(PG8_SB(1, 1), b3 + hstep, voffB); PG8_STAGE(PG8_SA(1, 0), a3, voffA);
            PG8_WAIT_V(8); PG8_WAIT_L(0); PG8_BAR; if (!cur.half) { PG8_MMA(1, 0, At, B0); PG8_MMA(1, 1, At, B1); } PG8_BAR; PG8_SCHED;
            } else {
            PG8_LDB(B0, 0, 0); PG8_SCHED; PG8_LDA(At, 0, 0); PG8_STAGE(PG8_SA(1, 1), a1 + hstep, voffA);
            PG8_WAIT_L(8); PG8_BAR; PG8_WAIT_L(0); PG8_MMA(0, 0, At, B0); PG8_BAR; PG8_SCHED;
            PG8_LDB(B1, 0, 1); PG8_STAGE(PG8_SB(0, 0), b2, voffB);
            PG8_BAR; PG8_WAIT_L(0); PG8_MMA(0, 1, At, B1); PG8_BAR;
            PG8_LDA(At, 0, 1); PG8_STAGE(PG8_SA(0, 0), a2, voffA);
            PG8_BAR; PG8_WAIT_L(0); if (!cur.half) { PG8_MMA(1, 0, At, B0); } PG8_BAR; PG8_SCHED;
            PG8_STAGE(PG8_SB(0, 1), b2 + hstep, voffB);
            PG8_WAIT_V(6); PG8_BAR; if (!cur.half) { PG8_MMA(1, 1, At, B1); } PG8_BAR;
            PG8_LDB(B0, 1, 0); PG8_SCHED; PG8_LDA(At, 1, 0); PG8_STAGE(PG8_SA(0, 1), a2 + hstep, voffA);
            PG8_WAIT_L(8); PG8_BAR; PG8_WAIT_L(0); PG8_MMA(0, 0, At, B0); PG8_BAR; PG8_SCHED;
            PG8_LDB(B1, 1, 1); PG8_STAGE(PG8_SB(1, 0), b3, voffB);
            PG8_BAR; PG8_WAIT_L(0); PG8_MMA(0, 1, At, B1); PG8_BAR;
            PG8_LDA(At, 1, 1); PG8_STAGE(PG8_SA(1, 0), a3, voffA);
            PG8_BAR; PG8_WAIT_L(0); if (!cur.half) { PG8_MMA(1, 0, At, B0); } PG8_BAR; PG8_SCHED;
            PG8_STAGE(PG8_SB(1, 1), b3 + hstep, voffB);
            PG8_WAIT_V(6); PG8_BAR; if (!cur.half) { PG8_MMA(1, 1, At, B1); } PG8_BAR;
            }
        }
        if constexpr (ALIGN_EPI) { if (wr == 0) PG8_BAR; }
        if constexpr (!Epi::AFTER_DRAIN) { E(acc, cur, wr, wc, fr, fq); S.done(cur); }
        if (!has_next) break;
#pragma unroll
        for (int a = 0; a < 2; ++a)
#pragma unroll
            for (int b = 0; b < 2; ++b)
#pragma unroll
                for (int m = 0; m < 4; ++m)
#pragma unroll
                    for (int n = 0; n < 2; ++n) acc[a][b][m][n] = (f32x4){0.f, 0.f, 0.f, 0.f};
        cur = nxt; cA = nA; cB = nB; ++ui;
        if constexpr (ALIGN_EPI) { if (wr == 1) PG8_BAR; }
    }
    PG8_WAIT_V(0);
    if constexpr (!ALIGN_EPI) { if (wr == 0) PG8_BAR; }
    PG8_BAR;
    if constexpr (Epi::AFTER_DRAIN) { E.fused(acc, cur, wr, wc, fr, fq, lds, wid, lane); S.done(cur); }
#undef PG8_SA
#undef PG8_SB
#undef PG8_STAGE
#undef PG8_LDA
#undef PG8_LDB
#undef PG8_MMA
#undef PG8_WAIT_V
#undef PG8_WAIT_L
#undef PG8_BAR
#undef PG8_SCHED
}
}

#define GAS __attribute__((address_space(1)))
#define LAS __attribute__((address_space(3)))
typedef unsigned short bf16;
typedef float f32x4 __attribute__((ext_vector_type(4)));
typedef float f32x16 __attribute__((ext_vector_type(16)));
typedef short bf16x8 __attribute__((ext_vector_type(8)));
typedef short s16x4 __attribute__((ext_vector_type(4)));
typedef unsigned u32x4 __attribute__((ext_vector_type(4)));
typedef unsigned u32x2 __attribute__((ext_vector_type(2)));

constexpr int BATCH = 4, SEQ = 4096, D = 1024, T = BATCH * SEQ, DFF = 2816, MEML = 256, MEMT = BATCH * MEML;
constexpr int NH = 8, HD = 128, MH = 4, MHD = 256, NBLK = SEQ / 256;
constexpr float LOG2E = 1.4426950408889634f;
constexpr float QS_MOBA = 0.08838834764831845f * LOG2E;
constexpr float QS_MEM = 0.0625f * LOG2E;
constexpr int NTHREADS = 512, NWAVES = 8;
constexpr int LDS_BYTES = 131072 + 1024 + 16384;

constexpr size_t MiB = 1u << 20;
constexpr size_t WS_WIN = 0;
constexpr size_t WS_WOUT = WS_WIN + 6 * MiB;
constexpr size_t WS_MWQ = WS_WOUT + 2 * MiB;
constexpr size_t WS_MWKV = WS_MWQ + 4 * MiB;
constexpr size_t WS_MWO = WS_MWKV + 8 * MiB;
constexpr size_t WGU_BYTES = (size_t)2 * DFF * D * 2;
constexpr size_t WS_WGU = WS_MWO + 4 * MiB;
constexpr size_t WDN_BYTES = (size_t)D * DFF * 2;
constexpr size_t WS_WDN = WS_WGU + 2 * WGU_BYTES;
constexpr size_t WS_WKVQ = WS_WDN + 2 * WDN_BYTES;
constexpr size_t WS_MOWO = WS_WKVQ + 6 * MiB;
constexpr size_t WS_XB = 68 * MiB;
static_assert(WS_MOWO + 2 * MiB <= WS_XB, "weights fit");
constexpr size_t WS_R = WS_XB + 32 * MiB;
constexpr size_t WS_R0 = WS_R, WS_R1 = WS_R + 32 * MiB, WS_R2 = WS_R + 64 * MiB;
constexpr size_t WS_SMALL = WS_R + 96 * MiB;
constexpr size_t WS_SS = WS_SMALL;
constexpr size_t WS_KVM = WS_SS + 1 * MiB;
constexpr size_t WS_MEMN = WS_KVM + 8 * MiB;
constexpr size_t WS_KMP = WS_MEMN + 4 * MiB;
constexpr size_t WS_ROPE = WS_KMP + 1 * MiB;
constexpr size_t WS_BAR = WS_ROPE + 2 * MiB;
constexpr size_t WS_END = WS_BAR + 1 * MiB;
static_assert(WS_END <= 256 * MiB, "d_ws map");

__device__ __forceinline__ float bf2f(unsigned short b) { return __builtin_bit_cast(float, (unsigned)b << 16); }
__device__ __forceinline__ float wave_sum(float v) {
#pragma unroll
    for (int o = 1; o < 64; o <<= 1) v += __shfl_xor(v, o);
    return v;
}

__device__ __forceinline__ float xhalf_max(float v) { const unsigned u = __builtin_bit_cast(unsigned, v); const auto rr = __builtin_amdgcn_permlane32_swap(u, u, false, false);
    return fmaxf(__builtin_bit_cast(float, (unsigned)rr[0]), __builtin_bit_cast(float, (unsigned)rr[1])); }

#define MFMA32(a, b, c) __builtin_amdgcn_mfma_f32_32x32x16_bf16((a), (b), (c), 0, 0, 0)
__device__ __forceinline__ s16x4 vtr(LAS const char* p) { return __builtin_bit_cast(s16x4, __builtin_amdgcn_ds_read_tr16_b64_v4i16((LAS s16x4*)p)); }

template <int DQK, int VW, int KT> struct ATile {
    static constexpr int KCH = DQK / 8, VCH = VW / 8;
    static constexpr int NK = KT * KCH / NTHREADS, NV = KT * VCH / NTHREADS;
    static constexpr int KBYTES = KT * DQK * 2, VBYTES = KT * VW * 2, STAGE = KBYTES + VBYTES;
    static_assert(NK >= 1 && NV >= 1, "tile too small for 512 threads");
    u32x4 kr[NK], vr[NV];
    __device__ __forceinline__ void load(const bf16* Kg, size_t kpitch, const bf16* Vg, size_t vpitch, int tid) {
#pragma unroll
        for (int i = 0; i < NK; ++i) { const int idx = tid + i * NTHREADS, row = idx / KCH, c = idx % KCH; kr[i] = *(const u32x4*)(Kg + (size_t)row * kpitch + c * 8); }
#pragma unroll
        for (int i = 0; i < NV; ++i) { const int idx = tid + i * NTHREADS, row = idx / VCH, c = idx % VCH; vr[i] = *(const u32x4*)(Vg + (size_t)row * vpitch + c * 8); }
    }
    __device__ __forceinline__ void store(LAS char* stage, int tid) const {
#pragma unroll
        for (int i = 0; i < NK; ++i) { const int idx = tid + i * NTHREADS, row = idx / KCH, c = idx % KCH; *(LAS u32x4*)(stage + row * (DQK * 2) + ((c ^ (row & 15)) << 4)) = kr[i]; }
#pragma unroll
        for (int i = 0; i < NV; ++i) { const int idx = tid + i * NTHREADS, row = idx / VCH, c = idx % VCH; *(LAS u32x4*)(stage + KBYTES + row * (VW * 2) + ((c ^ (4 * (row & 3))) << 4)) = vr[i]; }
    }
};

template <int DQK, int VW, int KT>
__device__ __forceinline__ void attn_tile(LAS const char* kb, LAS const char* vb, const bf16x8 (&qf)[DQK / 16], f32x16 (&o)[4], float& m, float& l, int voff, int lane, int lim, const int MODE  , const int pvar = 0) {
    constexpr int NSUB = KT / 32;
    const int r = lane & 31, h = lane >> 5;
    f32x16 st[NSUB];
#pragma unroll
    for (int sub = 0; sub < NSUB; ++sub)
#pragma unroll
        for (int i = 0; i < 16; ++i) st[sub][i] = 0.f;
#ifdef PROBE_VARIANTS
    if (pvar != 3)
#endif
#pragma unroll
    for (int s = 0; s < DQK / 16; ++s)
#pragma unroll
        for (int sub = 0; sub < NSUB; ++sub) {
            const int row = sub * 32 + r;
            const bf16x8 kf = *(LAS const bf16x8*)(kb + row * (DQK * 2) + (((2 * s + h) ^ (row & 15)) << 4));
            st[sub] = MFMA32(kf, qf[s], st[sub]);
        }
#ifdef PROBE_VARIANTS
    if (pvar != 1) {
#else
    {
#endif
    const float ninf = -__builtin_inff();
    if (MODE == 1) {
        const int lm = lim - 4 * h;
#pragma unroll
        for (int sub = 0; sub < NSUB; ++sub)
#pragma unroll
            for (int i = 0; i < 16; ++i) { const int kc = sub * 32 + (i & 3) + 8 * (i >> 2); st[sub][i] = (kc <= lm) ? st[sub][i] : ninf; }
    }
    float mx = ninf;
#pragma unroll
    for (int sub = 0; sub < NSUB; ++sub)
#pragma unroll
        for (int i = 0; i < 16; ++i) mx = fmaxf(mx, st[sub][i]);
    mx = xhalf_max(mx);
    float mnew = fmaxf(m, mx);
    float msafe = (mnew == ninf) ? 0.f : mnew;
    float mal = msafe;
    if (MODE == 2) { const bool rs = lim >= 0; mnew = rs ? mnew : m; mal = mnew; msafe = rs ? mnew : __builtin_inff(); }
    const float alpha = __builtin_amdgcn_exp2f(m - mal);
    float ps = 0.f;
#pragma unroll
    for (int sub = 0; sub < NSUB; ++sub)
#pragma unroll
        for (int i = 0; i < 16; ++i) { const float p = __builtin_amdgcn_exp2f(st[sub][i] - msafe); st[sub][i] = p; ps += p; }
    l = l * alpha + ps; m = mnew;
    if (__ballot(alpha != 1.0f) != 0ull) {
#pragma unroll
        for (int d = 0; d < 4; ++d) o[d] = o[d] * alpha;
    }
    }
    bf16x8 pf[KT / 16];
#pragma unroll
    for (int sub = 0; sub < NSUB; ++sub)
#pragma unroll
        for (int s = 0; s < 2; ++s) {
            u32x4 p; p.x = pg8::cvt_pk_bf16(st[sub][8 * s + 0], st[sub][8 * s + 1]); p.y = pg8::cvt_pk_bf16(st[sub][8 * s + 2], st[sub][8 * s + 3]);
            p.z = pg8::cvt_pk_bf16(st[sub][8 * s + 4], st[sub][8 * s + 5]); p.w = pg8::cvt_pk_bf16(st[sub][8 * s + 6], st[sub][8 * s + 7]);
            pf[sub * 2 + s] = __builtin_bit_cast(bf16x8, p);
        }
    const int i16 = lane & 15, q4 = i16 >> 2, p4 = i16 & 3, g = (lane >> 4) & 1;
#ifdef PROBE_VARIANTS
    if (pvar != 2)
#endif
#pragma unroll
    for (int ks = 0; ks < KT / 16; ++ks) {
        const int rlo = ks * 16 + 4 * h + q4, rhi = rlo + 8;
#pragma unroll
        for (int d = 0; d < 4; ++d) {
            const int c = (voff + d * 32 + 16 * g) >> 3;
            const s16x4 lo = vtr(vb + rlo * (VW * 2) + ((c ^ (4 * (rlo & 3))) << 4) + 8 * p4);
            const s16x4 hi = vtr(vb + rhi * (VW * 2) + ((c ^ (4 * (rhi & 3))) << 4) + 8 * p4);
            const bf16x8 vf = __builtin_shufflevector(lo, hi, 0, 1, 2, 3, 4, 5, 6, 7);
            o[d] = MFMA32(vf, pf[ks], o[d]);
        }
    }
}

__device__ __forceinline__ void attn_store(LAS char* wl, bf16* Orow0, const f32x16 (&o)[4], float l, int lane) {
    const int r = lane & 31, h = lane >> 5;
    l += __shfl_xor(l, 32);
    const float inv = 1.0f / l;
#pragma unroll
    for (int hh = 0; hh < 2; ++hh) {
#pragma unroll
        for (int dd = 0; dd < 2; ++dd)
#pragma unroll
            for (int g4 = 0; g4 < 4; ++g4) {
                const int d = 2 * hh + dd, c = 4 * dd + g4;
                u32x2 w; w.x = pg8::cvt_pk_bf16(o[d][4 * g4 + 0] * inv, o[d][4 * g4 + 1] * inv); w.y = pg8::cvt_pk_bf16(o[d][4 * g4 + 2] * inv, o[d][4 * g4 + 3] * inv);
                *(LAS u32x2*)(wl + r * 128 + ((c ^ (r & 7)) << 4) + 8 * h) = w;
            }
#pragma unroll
        for (int k = 0; k < 4; ++k) {
            const int idx = lane + 64 * k, row = idx >> 3, c = idx & 7;
            const u32x4 v = *(LAS const u32x4*)(wl + row * 128 + ((c ^ (row & 7)) << 4));
            __builtin_nontemporal_store(v, (u32x4*)(Orow0 + (size_t)row * D + hh * 64 + c * 8));
        }
    }
}

__device__ __forceinline__ void glds16(const void* gsrc, unsigned lds_dst) { unsigned keep;
    asm volatile("s_mov_b32 %0, m0\n\ts_mov_b32 m0, %2\n\ts_nop 0\n\tglobal_load_lds_dwordx4 %1, off\n\ts_mov_b32 m0, %0" : "=&s"(keep) : "v"(gsrc), "s"(lds_dst) : "memory"); }
__device__ __forceinline__ void memattn_phase(LAS char* lds, const bf16* QM, const bf16* KVM, bf16* AO, const pg8::StaticOrder S, int tid_in) {
    pg8::Unit un;
    for (int ui = 0; S.next(ui, un); ++ui) {
        int tid = tid_in; asm volatile("" : "+v"(tid));
        const int lane = tid & 63, w = tid >> 6, r = lane & 31, h = lane >> 5;
        const int b = un.pm / (SEQ / 256), grp = un.pm % (SEQ / 256), hd = un.pn;
        const size_t tok = (size_t)b * SEQ + grp * 256 + w * 32 + r;
        const bf16* Kg = KVM + (size_t)(b * MEML) * 2048 + hd * MHD; const bf16* Vg = Kg + 1024;
        {
            const int wu = __builtin_amdgcn_readfirstlane(w);
            const unsigned sbase = (unsigned)(size_t)lds;
#pragma unroll
            for (int i = 0; i < 16; ++i) {
                const int row = 32 * w + 2 * i + (lane >> 5), cp = lane & 31;
                glds16(Kg + (size_t)row * 2048 + (cp ^ (row & 15)) * 8, __builtin_amdgcn_readfirstlane(sbase + (32 * wu + 2 * i) * 512));
            }
        }
        bf16x8 qf[16];
#pragma unroll
        for (int s = 0; s < 16; ++s) qf[s] = *(const bf16x8*)(QM + tok * D + hd * MHD + 16 * s + 8 * h);
        asm volatile("s_waitcnt vmcnt(0)" ::: "memory");
        __syncthreads();
        float mx = -__builtin_inff();
#pragma unroll
        for (int tp = 0; tp < 1; ++tp) {
            f32x16 s0, s1;
#pragma unroll
            for (int i = 0; i < 16; ++i) { s0[i] = 0.f; s1[i] = 0.f; }
            const int row0 = tp * 64 + r, row1 = row0 + 32;
#pragma unroll
            for (int s = 0; s < 16; ++s) {
                const bf16x8 k0 = *(LAS const bf16x8*)(lds + row0 * 512 + (((2 * s + h) ^ (row0 & 15)) << 4));
                const bf16x8 k1 = *(LAS const bf16x8*)(lds + row1 * 512 + (((2 * s + h) ^ (row1 & 15)) << 4));
                s0 = MFMA32(k0, qf[s], s0); s1 = MFMA32(k1, qf[s], s1);
            }
#pragma unroll
            for (int i = 0; i < 16; ++i) mx = fmaxf(mx, fmaxf(s0[i], s1[i]));
        }
        mx = xhalf_max(mx);
        float l = 0.f;
        bf16x8 pf[16];
#pragma unroll
        for (int tp = 0; tp < 4; ++tp) {
            f32x16 s0, s1;
#pragma unroll
            for (int i = 0; i < 16; ++i) { s0[i] = 0.f; s1[i] = 0.f; }
            const int row0 = tp * 64 + r, row1 = row0 + 32;
#pragma unroll
            for (int s = 0; s < 16; ++s) {
                const bf16x8 k0 = *(LAS const bf16x8*)(lds + row0 * 512 + (((2 * s + h) ^ (row0 & 15)) << 4));
                const bf16x8 k1 = *(LAS const bf16x8*)(lds + row1 * 512 + (((2 * s + h) ^ (row1 & 15)) << 4));
                s0 = MFMA32(k0, qf[s], s0); s1 = MFMA32(k1, qf[s], s1);
            }
#pragma unroll
            for (int i = 0; i < 16; ++i) { s0[i] = __builtin_amdgcn_exp2f(s0[i] - mx); s1[i] = __builtin_amdgcn_exp2f(s1[i] - mx); l += s0[i] + s1[i]; }
#pragma unroll
            for (int sh = 0; sh < 2; ++sh) {
                u32x4 p0, p1;
                p0.x = pg8::cvt_pk_bf16(s0[8 * sh + 0], s0[8 * sh + 1]); p0.y = pg8::cvt_pk_bf16(s0[8 * sh + 2], s0[8 * sh + 3]); p0.z = pg8::cvt_pk_bf16(s0[8 * sh + 4], s0[8 * sh + 5]); p0.w = pg8::cvt_pk_bf16(s0[8 * sh + 6], s0[8 * sh + 7]);
                p1.x = pg8::cvt_pk_bf16(s1[8 * sh + 0], s1[8 * sh + 1]); p1.y = pg8::cvt_pk_bf16(s1[8 * sh + 2], s1[8 * sh + 3]); p1.z = pg8::cvt_pk_bf16(s1[8 * sh + 4], s1[8 * sh + 5]); p1.w = pg8::cvt_pk_bf16(s1[8 * sh + 6], s1[8 * sh + 7]);
                pf[tp * 4 + sh] = __builtin_bit_cast(bf16x8, p0); pf[tp * 4 + 2 + sh] = __builtin_bit_cast(bf16x8, p1);
            }
        }
        l += __shfl_xor(l, 32);
        __syncthreads();
        int tid2 = tid_in; asm volatile("" : "+v"(tid2));
        {
            const int w2 = tid2 >> 6, l2 = tid2 & 63, wu2 = __builtin_amdgcn_readfirstlane(w2);
            const unsigned sbase = (unsigned)(size_t)lds;
#pragma unroll
            for (int i = 0; i < 16; ++i) {
                const int row = 32 * w2 + 2 * i + (l2 >> 5), cp = l2 & 31;
                glds16(Vg + (size_t)row * 2048 + (cp ^ (4 * (row & 3))) * 8, __builtin_amdgcn_readfirstlane(sbase + (32 * wu2 + 2 * i) * 512));
            }
        }
        asm volatile("s_waitcnt vmcnt(0)" ::: "memory");
        __syncthreads();
        const float inv = 1.0f / l;
        const int lane2 = tid2 & 63, h2 = lane2 >> 5;
        bf16* Og = AO + ((size_t)b * SEQ + grp * 256 + (tid2 >> 6) * 32 + (lane2 & 31)) * D + hd * MHD;
        const int i16 = lane2 & 15, q4 = i16 >> 2, p4 = i16 & 3, g = (lane2 >> 4) & 1;
#pragma unroll
        for (int dh = 0; dh < 2; ++dh) {
            f32x16 o[4];
#pragma unroll
            for (int d = 0; d < 4; ++d)
#pragma unroll
                for (int i = 0; i < 16; ++i) o[d][i] = 0.f;
#pragma unroll
            for (int ks = 0; ks < 16; ++ks) {
                const int rlo = ks * 16 + 4 * h2 + q4, rhi = rlo + 8;
#pragma unroll
                for (int d = 0; d < 4; ++d) {
                    const int cc = ((dh * 4 + d) * 32 + 16 * g) >> 3;
                    const s16x4 lo = vtr(lds + rlo * 512 + ((cc ^ (4 * (rlo & 3))) << 4) + 8 * p4);
                    const s16x4 hi = vtr(lds + rhi * 512 + ((cc ^ (4 * (rhi & 3))) << 4) + 8 * p4);
                    const bf16x8 vf = __builtin_shufflevector(lo, hi, 0, 1, 2, 3, 4, 5, 6, 7);
                    o[d] = MFMA32(vf, pf[ks], o[d]);
                }
            }
            {
                LAS char* wl = lds + 131072 + 1024 + (tid2 >> 6) * 2048;
                const int r2 = lane2 & 31;
                bf16* Orow0 = AO + ((size_t)b * SEQ + grp * 256 + (tid2 >> 6) * 32) * D + hd * MHD;
#pragma unroll
                for (int d = 0; d < 4; ++d) {
#pragma unroll
                    for (int g4 = 0; g4 < 4; ++g4) {
                        u32x2 wv; wv.x = pg8::cvt_pk_bf16(o[d][4 * g4 + 0] * inv, o[d][4 * g4 + 1] * inv); wv.y = pg8::cvt_pk_bf16(o[d][4 * g4 + 2] * inv, o[d][4 * g4 + 3] * inv);
                        *(LAS u32x2*)(wl + r2 * 64 + ((g4 ^ (r2 & 3)) << 4) + 8 * h2) = wv;
                    }
#pragma unroll
                    for (int k = 0; k < 2; ++k) {
                        const int idx = lane2 + 64 * k, row = idx >> 2, c = idx & 3;
                        const u32x4 v = *(LAS const u32x4*)(wl + row * 64 + ((c ^ (row & 3)) << 4));
                        __builtin_nontemporal_store(v, (u32x4*)(Orow0 + (size_t)row * D + (dh * 4 + d) * 32 + c * 8));
                    }
                }
            }
        }
        __syncthreads();
    }
}

__device__ __forceinline__ void moba_dma(LAS char* stage, const bf16* Kt, const bf16* Vt, int w, int lane) {
    const unsigned sbase = (unsigned)(size_t)stage;
#pragma unroll
    for (int i = 0; i < 2; ++i) {
        const int row = w * 8 + i * 4 + (lane >> 4), cp = lane & 15;
        const int ck = cp ^ (row & 15), cv = cp ^ (4 * (row & 3));
        glds16(Kt + (size_t)row * D + ck * 8, __builtin_amdgcn_readfirstlane(sbase + (w * 8 + i * 4) * 256));
        glds16(Vt + (size_t)row * D + cv * 8, __builtin_amdgcn_readfirstlane(sbase + 16384 + (w * 8 + i * 4) * 256));
    }
}

__device__ __forceinline__ void moba_phase(LAS char* lds, const bf16* QB, const bf16* KB, const bf16* VB, bf16* AO, const float* kmp, int G, int c, int tid_in, const int pvar = 0) {
    typedef ATile<128, 128, 64> TL;
    for (int u = c; u < 2 * BATCH * NH * 8; u += G) {
        int tid = tid_in; asm volatile("" : "+v"(tid));
        const int lane = tid & 63, w = tid >> 6, r = lane & 31, h = lane >> 5;
        const int uu = (u < 256) ? u : (u - 256);
        const int bh = uu >> 3, qb = (u < 256) ? (15 - (uu & 7)) : (uu & 7), b = bh / NH, hd = bh % NH;
        const size_t tok = (size_t)b * SEQ + qb * 256 + w * 32 + r;
        const bf16* Kh = KB + (size_t)b * SEQ * D + hd * HD; const bf16* Vh = VB + (size_t)b * SEQ * D + hd * HD;
        const int wu = __builtin_amdgcn_readfirstlane(w);
        constexpr int STG = 32768;
#define MOBA_TILE_OFF(n) ((size_t)((((n) < 4) ? qb : (((n) - 4) >> 2)) * 256 + ((n) & 3) * 64) * D)
        moba_dma(lds, Kh + MOBA_TILE_OFF(0), Vh + MOBA_TILE_OFF(0), wu, lane);
        moba_dma(lds + STG, Kh + MOBA_TILE_OFF(1), Vh + MOBA_TILE_OFF(1), wu, lane);
        bf16x8 qf[8];
#pragma unroll
        for (int s = 0; s < 8; ++s) qf[s] = *(const bf16x8*)(QB + tok * D + hd * HD + 16 * s + 8 * h);
        unsigned sel = 0u;
#ifdef PROBE_VARIANTS
        if (qb > 0 && pvar != 7) {
#else
        if (qb > 0) {
#endif
            LAS char* gfr = lds + 3 * 32768;
            {
                const int jb = r & 15;
                const float* p0 = kmp + ((size_t)(b * NBLK + jb) * 2) * 1024 + hd * HD + 16 * w + 8 * h;
                const f32x4 a0 = *(const f32x4*)p0, a1 = *(const f32x4*)(p0 + 4), b0 = *(const f32x4*)(p0 + 1024), b1 = *(const f32x4*)(p0 + 1028);
                const f32x4 k0 = (a0 + b0) * (1.0f / 256.0f), k1 = (a1 + b1) * (1.0f / 256.0f);
                const u32x4 hi = pg8::pack8(k0, k1);
                f32x4 h0, h1;
                h0[0] = __builtin_bit_cast(float, hi.x << 16); h0[1] = __builtin_bit_cast(float, hi.x & 0xffff0000u); h0[2] = __builtin_bit_cast(float, hi.y << 16); h0[3] = __builtin_bit_cast(float, hi.y & 0xffff0000u);
                h1[0] = __builtin_bit_cast(float, hi.z << 16); h1[1] = __builtin_bit_cast(float, hi.z & 0xffff0000u); h1[2] = __builtin_bit_cast(float, hi.w << 16); h1[3] = __builtin_bit_cast(float, hi.w & 0xffff0000u);
                const u32x4 lo = pg8::pack8(k0 - h0, k1 - h1);
                *(LAS u32x4*)(gfr + (w * 64 + lane) * 16) = (r < 16) ? hi : lo;
            }
            __syncthreads();
            f32x16 gt;
#pragma unroll
            for (int i = 0; i < 16; ++i) gt[i] = 0.f;
#pragma unroll
            for (int s = 0; s < 8; ++s) gt = MFMA32(*(LAS const bf16x8*)(gfr + (s * 64 + lane) * 16), qf[s], gt);
#pragma unroll
            for (int i = 0; i < 8; ++i) gt[i] += gt[i + 8];
            float mine[8], oth[8];
#pragma unroll
            for (int i = 0; i < 8; ++i) { mine[i] = gt[i]; oth[i] = __shfl_xor(gt[i], 32); }
#pragma unroll
            for (int rep = 0; rep < 3; ++rep) {
                float best = -__builtin_inff(); int bi = -1;
#pragma unroll
                for (int i = 0; i < 8; ++i) {
                    const int b1 = (i & 3) + 8 * (i >> 2) + 4 * h, b2 = (i & 3) + 8 * (i >> 2) + 4 * (1 - h);
                    const bool ok1 = (b1 < qb) && !((sel >> b1) & 1u); if (ok1 && (bi < 0 || mine[i] > best)) { best = mine[i]; bi = b1; }
                    const bool ok2 = (b2 < qb) && !((sel >> b2) & 1u); if (ok2 && (bi < 0 || oth[i] > best)) { best = oth[i]; bi = b2; }
                }
                if (bi >= 0) sel |= 1u << bi;
            }
        }
        f32x16 o[4];
#pragma unroll
        for (int d = 0; d < 4; ++d)
#pragma unroll
            for (int i = 0; i < 16; ++i) o[d][i] = 0.f;
        float m = -__builtin_inff(), l = 0.f;
#ifdef PROBE_VARIANTS
        const int NT = (pvar == 4 || pvar == 7 || pvar == 8) ? 0 : 4 * (qb + 1);
#elif defined(PROBE_HALF_TILES)
        const int NT = 4 + 2 * qb;
#else
        const int NT = 4 * (qb + 1);
#endif
        __builtin_amdgcn_s_waitcnt(0);
        const int qloc = w * 32 + r;
        for (int pp = 0; 2 * pp < NT; ++pp) {
            asm volatile("s_waitcnt vmcnt(0)" ::: "memory");
            __builtin_amdgcn_s_barrier();
            if (2 * pp + 2 < NT) { const int n = 2 * pp + 2; LAS char* sn = lds + ((pp + 1) & 1) * 65536;
                moba_dma(sn, Kh + MOBA_TILE_OFF(n), Vh + MOBA_TILE_OFF(n), wu, lane); moba_dma(sn + STG, Kh + MOBA_TILE_OFF(n + 1), Vh + MOBA_TILE_OFF(n + 1), wu, lane); }
#pragma unroll
            for (int hh = 0; hh < 2; ++hh) {
                const int it = 2 * pp + hh;
                LAS const char* st = lds + (pp & 1) * 65536 + hh * STG;
                const int kt = it & 3;
                int lim; bool active;
                if (it < 4) { lim = qloc - kt * 64; active = (kt * 64 <= w * 32 + 31); }
                else { const int j = (it - 4) >> 2; const bool s1 = (sel >> j) & 1u; lim = s1 ? (1 << 30) : -1; active = (__ballot(s1) != 0ull); }
#ifdef PROBE_VARIANTS
                if (pvar == 5) active = false;
#endif
                if (active) {
                    const int mode = (it >= 4) ? 2 : ((kt * 64 + 63 > w * 32) ? 1 : 0);
                    attn_tile<128, 128, 64>(st, st + 16384, qf, o, m, l, 0, lane, lim, mode, pvar);
                }
            }
        }
#undef MOBA_TILE_OFF
        __builtin_amdgcn_s_barrier();
#ifdef PROBE_VARIANTS
        if (pvar != 8)
#endif
        attn_store(lds + 65536 + w * 4096, AO + (tok - r) * D + hd * HD, o, l, lane);
    }
}

__host__ __device__ __forceinline__ int hperm(int d) {
    if (d < 16) return 32 * (d >> 2) + (d & 3);
    if (d < 32) return 32 * ((d - 16) >> 2) + 4 + (d & 3);
    const int k = d - 32; return 32 * (k / 24) + 8 + (k % 24);
}
__device__ __forceinline__ void transpose_item(const float* W, int K, int N, const float* gain, float scale, bf16* WT, int k0, int n0, int drow0, int lane, const bool hp = false) {
    const int q = lane >> 4, c = lane & 15;
    const float* src = W + (size_t)(k0 + 16 * q) * N + n0 + 4 * c;
    f32x4 v[16];
#pragma unroll
    for (int j = 0; j < 16; ++j) v[j] = __builtin_nontemporal_load((const f32x4*)(src + (size_t)j * N));
    float gs[16];
    if (gain) {
#pragma unroll
        for (int j4 = 0; j4 < 4; ++j4) { const f32x4 gv = *(const f32x4*)(gain + k0 + 16 * q + 4 * j4); gs[4 * j4] = gv[0] * scale; gs[4 * j4 + 1] = gv[1] * scale; gs[4 * j4 + 2] = gv[2] * scale; gs[4 * j4 + 3] = gv[3] * scale; }
    } else {
#pragma unroll
        for (int j = 0; j < 16; ++j) gs[j] = scale;
    }
#pragma unroll
    for (int e = 0; e < 4; ++e) {
        u32x4 lo, hi;
        lo.x = pg8::cvt_pk_bf16(v[0][e] * gs[0], v[1][e] * gs[1]); lo.y = pg8::cvt_pk_bf16(v[2][e] * gs[2], v[3][e] * gs[3]);
        lo.z = pg8::cvt_pk_bf16(v[4][e] * gs[4], v[5][e] * gs[5]); lo.w = pg8::cvt_pk_bf16(v[6][e] * gs[6], v[7][e] * gs[7]);
        hi.x = pg8::cvt_pk_bf16(v[8][e] * gs[8], v[9][e] * gs[9]); hi.y = pg8::cvt_pk_bf16(v[10][e] * gs[10], v[11][e] * gs[11]);
        hi.z = pg8::cvt_pk_bf16(v[12][e] * gs[12], v[13][e] * gs[13]); hi.w = pg8::cvt_pk_bf16(v[14][e] * gs[14], v[15][e] * gs[15]);
        const int dr = hp ? ((drow0 & ~127) + hperm((drow0 & 127) + 4 * c + e)) : (drow0 + 4 * c + e);
        bf16* dst = WT + (size_t)dr * K + k0 + 16 * q;
        *(u32x4*)dst = lo; *(u32x4*)(dst + 8) = hi;
    }
}

struct Args { const void* in[20]; float* out; unsigned char* ws; int ph_lo, ph_hi; };

__device__ __forceinline__ void prologue(const Args& a, LAS char* lds, int G, int c, int tid) {
    const int lane = tid & 63, w = tid >> 6;
    const int gw = c * NWAVES + w, NGW = G * NWAVES;
    unsigned char* ws = a.ws;
    const float* norm_mix = (const float*)a.in[3]; const float* norm_mem = (const float*)a.in[4]; const float* norm_memkv = (const float*)a.in[5]; const float* norm_ffn = (const float*)a.in[6];
    constexpr int I_IN = 16 * 48, I_SQ = 16 * 16, I_KV = 16 * 32, I_GU = 16 * 88, I_DN = 44 * 16;
    constexpr int NITEMS = I_IN + 7 * I_SQ + 3 * I_KV + 2 * I_GU + 2 * I_DN;
    for (int it = gw; it < NITEMS; it += NGW) {
        int rr = it; const float* W; int K, N; const float* gain = nullptr; float scale = 1.f; bf16* WT; int mode = 0;
        if (rr < I_IN) { W = (const float*)a.in[8]; K = D; N = 3 * D; gain = norm_mix; WT = (bf16*)(ws + WS_WIN); mode = 1; }
        else if ((rr -= I_IN) < I_SQ) { W = (const float*)a.in[10]; K = D; N = D; WT = (bf16*)(ws + WS_WOUT); }
        else if ((rr -= I_SQ) < 2 * I_SQ) { const int l = rr / I_SQ; rr -= l * I_SQ; W = (const float*)a.in[15] + (size_t)l * D * D; K = D; N = D; gain = norm_mem + l * D; scale = QS_MEM; WT = (bf16*)(ws + WS_MWQ) + (size_t)l * D * D; }
        else if ((rr -= 2 * I_SQ) < 2 * I_KV) { const int l = rr / I_KV; rr -= l * I_KV; W = (const float*)a.in[16] + (size_t)l * D * 2 * D; K = D; N = 2 * D; WT = (bf16*)(ws + WS_MWKV) + (size_t)l * 2 * D * D; }
        else if ((rr -= 2 * I_KV) < 2 * I_SQ) { const int l = rr / I_SQ; rr -= l * I_SQ; W = (const float*)a.in[17] + (size_t)l * D * D; K = D; N = D; WT = (bf16*)(ws + WS_MWO) + (size_t)l * D * D; }
        else if ((rr -= 2 * I_SQ) < 2 * I_GU) { const int l = rr / I_GU; rr -= l * I_GU; W = (const float*)a.in[18] + (size_t)l * D * 2 * DFF; K = D; N = 2 * DFF; gain = norm_ffn + l * D; WT = (bf16*)(ws + WS_WGU + l * WGU_BYTES); mode = 2; }
        else if ((rr -= 2 * I_GU) < 2 * I_DN) { const int l = rr / I_DN; rr -= l * I_DN; W = (const float*)a.in[19] + (size_t)l * DFF * D; K = DFF; N = D; WT = (bf16*)(ws + WS_WDN + l * WDN_BYTES); }
        else if ((rr -= 2 * I_DN) < I_KV) { W = (const float*)a.in[12]; K = D; N = 2 * D; gain = (const float*)a.in[11]; WT = (bf16*)(ws + WS_WKVQ); mode = 4; }
        else if ((rr -= I_KV) < I_SQ) { W = (const float*)a.in[13]; K = D; N = D; gain = norm_mix + D; scale = QS_MOBA; WT = (bf16*)(ws + WS_WKVQ) + (size_t)2 * D * D; mode = 3; }
        else { rr -= I_SQ; W = (const float*)a.in[14]; K = D; N = D; WT = (bf16*)(ws + WS_MOWO); }
        const int nblk = N / 64, kb = rr / nblk, nb = rr % nblk, n0 = nb * 64; int drow0 = n0;
        if (mode == 1) { if (n0 < D) drow0 = 2 * D + n0; else if (n0 < 2 * D) { const int ch = n0 - D; drow0 = (ch >> 7) * 256 + (ch & 127); } else { const int ch = n0 - 2 * D; drow0 = (ch >> 7) * 256 + 128 + (ch & 127); } }
        else if (mode == 2) { if (n0 < DFF) drow0 = (n0 >> 7) * 256 + (n0 & 127); else { const int ch = n0 - DFF; drow0 = (ch >> 7) * 256 + 128 + (ch & 127); } }
        transpose_item(W, K, N, gain, scale, WT, kb * 64, n0, drow0, lane, mode == 3 || (mode == 4 && n0 < D));
    }
    { const float* x = (const float*)a.in[0]; bf16* XB = (bf16*)(ws + WS_XB); float* SS = (float*)(ws + WS_SS);
      for (int mrow = gw; mrow < T; mrow += NGW) {
          const f32x4* xr = (const f32x4*)(x + (size_t)mrow * D) + lane; f32x4 v[4]; float s = 0.f;
#pragma unroll
          for (int j = 0; j < 4; ++j) { v[j] = __builtin_nontemporal_load(&xr[64 * j]); s += (v[j][0] * v[j][0] + v[j][1] * v[j][1]) + (v[j][2] * v[j][2] + v[j][3] * v[j][3]); }
          s = wave_sum(s);
          u32x2* o8 = (u32x2*)(XB + (size_t)mrow * D) + lane;
#pragma unroll
          for (int j = 0; j < 4; ++j) { u32x2 p; p.x = pg8::cvt_pk_bf16(v[j][0], v[j][1]); p.y = pg8::cvt_pk_bf16(v[j][2], v[j][3]); o8[64 * j] = p; }
          if (lane < 16) SS[(size_t)mrow * 16 + lane] = (lane == 0) ? s : 0.f;
      } }
    { const float* mem = (const float*)a.in[1];
      for (int it = gw; it < 2 * MEMT; it += NGW) {
          const int l = it / MEMT, mrow = it % MEMT; const float* gl = norm_memkv + l * D;
          const f32x4* xr = (const f32x4*)(mem + (size_t)mrow * D) + lane; f32x4 v[4]; float s = 0.f;
#pragma unroll
          for (int j = 0; j < 4; ++j) { v[j] = xr[64 * j]; s += (v[j][0] * v[j][0] + v[j][1] * v[j][1]) + (v[j][2] * v[j][2] + v[j][3] * v[j][3]); }
          const float rs = rsqrtf(wave_sum(s) * (1.0f / D) + pg8::RMS_EPS);
          u32x2* o8 = (u32x2*)((bf16*)(ws + WS_MEMN) + (size_t)l * MEMT * D + (size_t)mrow * D) + lane;
#pragma unroll
          for (int j = 0; j < 4; ++j) { const f32x4 gv = ((const f32x4*)gl)[lane + 64 * j]; u32x2 p; p.x = pg8::cvt_pk_bf16(v[j][0] * rs * gv[0], v[j][1] * rs * gv[1]); p.y = pg8::cvt_pk_bf16(v[j][2] * rs * gv[2], v[j][3] * rs * gv[3]); o8[64 * j] = p; }
      } }
    { const int* pos = (const int*)a.in[2]; float* rope = (float*)(ws + WS_ROPE);
      for (int e = c * NTHREADS + tid; e < T * 16; e += G * NTHREADS) {
          const int tkn = e >> 4, i = e & 15;
          const float inv_freq = exp2f(-(float)i * (18.931568569324174f / 16.0f));
          const float ang = (float)pos[tkn] * inv_freq;
          double rev = (double)ang * 0.15915494309189535; rev -= rint(rev);
          const float rf = (float)rev;
          rope[2 * e] = __builtin_amdgcn_cosf(rf); rope[2 * e + 1] = __builtin_amdgcn_sinf(rf);
      } }
}

__device__ __forceinline__ void conv_phase(const bf16* Z, const bf16* BG, bf16* OUT, const float* cw, int nb, int bid, int tid) {
    const int nitems = (T / 8) * 128;
    for (int item = bid * NTHREADS + tid; item < nitems; item += nb * NTHREADS) {
        const int tg = item >> 7, cc = item & 127, t0 = tg * 8, ch0 = cc * 8;
        float wv[3][8];
#pragma unroll
        for (int j = 0; j < 3; ++j) { const f32x4 a0 = *(const f32x4*)(cw + j * D + ch0), a1 = *(const f32x4*)(cw + j * D + ch0 + 4);
#pragma unroll
            for (int e = 0; e < 4; ++e) { wv[j][e] = a0[e]; wv[j][4 + e] = a1[e]; } }
        float z2[8], z1[8];
        const bool first = (t0 % SEQ) == 0;
        u32x4 r2 = (u32x4){0u, 0u, 0u, 0u}, r1 = r2;
        if (!first) { r2 = *(const u32x4*)(Z + (size_t)(t0 - 2) * D + ch0); r1 = *(const u32x4*)(Z + (size_t)(t0 - 1) * D + ch0); }
#pragma unroll
        for (int e = 0; e < 4; ++e) { z2[2 * e] = __builtin_bit_cast(float, r2[e] << 16); z2[2 * e + 1] = __builtin_bit_cast(float, r2[e] & 0xffff0000u);
                                      z1[2 * e] = __builtin_bit_cast(float, r1[e] << 16); z1[2 * e + 1] = __builtin_bit_cast(float, r1[e] & 0xffff0000u); }
#pragma unroll
        for (int i = 0; i < 8; ++i) {
            const size_t off = (size_t)(t0 + i) * D + ch0;
            const u32x4 rz = *(const u32x4*)(Z + off), rb = *(const u32x4*)(BG + off);
            float zc[8], bg[8], ov[8];
#pragma unroll
            for (int e = 0; e < 4; ++e) { zc[2 * e] = __builtin_bit_cast(float, rz[e] << 16); zc[2 * e + 1] = __builtin_bit_cast(float, rz[e] & 0xffff0000u);
                                          bg[2 * e] = __builtin_bit_cast(float, rb[e] << 16); bg[2 * e + 1] = __builtin_bit_cast(float, rb[e] & 0xffff0000u); }
#pragma unroll
            for (int e = 0; e < 8; ++e) { ov[e] = bg[e] * (wv[0][e] * z2[e] + wv[1][e] * z1[e] + wv[2][e] * zc[e]); z2[e] = z1[e]; z1[e] = zc[e]; }
            u32x4 w; w.x = pg8::cvt_pk_bf16(ov[0], ov[1]); w.y = pg8::cvt_pk_bf16(ov[2], ov[3]); w.z = pg8::cvt_pk_bf16(ov[4], ov[5]); w.w = pg8::cvt_pk_bf16(ov[6], ov[7]);
            __builtin_nontemporal_store(w, (u32x4*)(OUT + off));
        }
    }
}

__device__ __forceinline__ void final_phase(const bf16* XBp, float* OUT, const float* SS, const float* gfin, int G, int c, int tid) {
    const int lane = tid & 63, w = tid >> 6, gw = c * NWAVES + w, NGW = G * NWAVES;
    for (int mrow = gw; mrow < T; mrow += NGW) {
        float s = (lane < 16) ? SS[(size_t)mrow * 16 + lane] : 0.f;
        s = wave_sum(s);
        const float rs = rsqrtf(s * (1.0f / D) + pg8::RMS_EPS);
        const u32x4* xr = (const u32x4*)(XBp + (size_t)mrow * D) + lane; f32x4* orow = (f32x4*)(OUT + (size_t)mrow * D) + 2 * lane;
#pragma unroll
        for (int j = 0; j < 2; ++j) {
            const u32x4 b = __builtin_nontemporal_load(&xr[64 * j]); const f32x4 g0 = ((const f32x4*)gfin)[2 * lane + 128 * j], g1 = ((const f32x4*)gfin)[2 * lane + 128 * j + 1];
            f32x4 v0, v1;
            v0[0] = __builtin_bit_cast(float, b.x << 16); v0[1] = __builtin_bit_cast(float, b.x & 0xffff0000u); v0[2] = __builtin_bit_cast(float, b.y << 16); v0[3] = __builtin_bit_cast(float, b.y & 0xffff0000u);
            v1[0] = __builtin_bit_cast(float, b.z << 16); v1[1] = __builtin_bit_cast(float, b.z & 0xffff0000u); v1[2] = __builtin_bit_cast(float, b.w << 16); v1[3] = __builtin_bit_cast(float, b.w & 0xffff0000u);
            __builtin_nontemporal_store(v0 * rs * g0, &orow[128 * j]); __builtin_nontemporal_store(v1 * rs * g1, &orow[128 * j + 1]);
        }
    }
}

#define XB_TMO      128
#define XB_XCNT(j)  (256  + 64 * (j))
#define XB_XSUB(j)  (1280 + 64 * (j))
#define XB_XGEN(j)  (2304 + 64 * (j))
#define XB_TOP      3328
#define XB_TOPGEN   3392
#define XCD_BAR_WORDS 3456
#define XB_SPIN_CAP (1u << 18)

__device__ __forceinline__ unsigned xb_ld(unsigned* p)              { return __hip_atomic_load(p, __ATOMIC_RELAXED, __HIP_MEMORY_SCOPE_AGENT); }
__device__ __forceinline__ unsigned xb_add(unsigned* p, unsigned v) { return __hip_atomic_fetch_add(p, v, __ATOMIC_RELAXED, __HIP_MEMORY_SCOPE_AGENT); }
__device__ __forceinline__ unsigned xb_xcc_id() { return (unsigned)__builtin_amdgcn_s_getreg((3 << 11) | 20) & 0xFu; }
#define XB_SPIN(cond, bar) do { unsigned _sp = 0; while (cond) { __builtin_amdgcn_s_sleep(1); \
    if ((++_sp & 255u) == 0u) { if (xb_ld(&(bar)[XB_TMO])) break; if (_sp > XB_SPIN_CAP) { atomicAdd(&(bar)[XB_TMO], 1u); break; } } } } while (0)

struct XcdBarrier {
    unsigned* bar; unsigned x;
    volatile LAS unsigned* st;
};

__device__ __forceinline__ XcdBarrier xcd_barrier_post(unsigned* bar, volatile LAS unsigned* st) {
    XcdBarrier b; b.bar = bar; b.x = xb_xcc_id(); b.st = st;
    if (threadIdx.x == 0) (void)xb_add(&bar[XB_XCNT(b.x)], 1u);
    return b;
}
__device__ __forceinline__ void xcd_barrier_complete(unsigned* bar, unsigned x, unsigned& nloc, unsigned& nx) {
    const unsigned G = gridDim.x * gridDim.y * gridDim.z;
    unsigned sum, cnt, mine, sp = 0u;
    for (;;) {
        sum = 0u; cnt = 0u; mine = 0u;
#pragma unroll
        for (unsigned j = 0; j < 16; ++j) { const unsigned c = xb_ld(&bar[XB_XCNT(j)]); sum += c; cnt += (c > 0u) ? 1u : 0u; mine = (j == x) ? c : mine; }
        if (sum == G) break;
        __builtin_amdgcn_s_sleep(1);
        if ((++sp & 255u) == 0u) { if (xb_ld(&bar[XB_TMO])) break; if (sp > XB_SPIN_CAP) { atomicAdd(&bar[XB_TMO], 1u); break; } }
    }
    nloc = mine > 0u ? mine : 1u; nx = cnt > 0u ? cnt : 1u;
}

__device__ __forceinline__ void xcd_barrier(const XcdBarrier& b) {
    asm volatile("s_waitcnt vmcnt(0)" ::: "memory");
    __syncthreads();
    if (threadIdx.x == 0) {
        unsigned* bar = b.bar;
        __builtin_amdgcn_s_waitcnt(0);
        unsigned nloc = b.st[0], nx = b.st[1];
        if (nloc == 0u) { xcd_barrier_complete(bar, b.x, nloc, nx); b.st[0] = nloc; b.st[1] = nx; }
        const unsigned old = xb_add(&bar[XB_XSUB(b.x)], 1u);
        const unsigned gen = old / nloc;
        if (old + 1u == (gen + 1u) * nloc) {
            __builtin_amdgcn_fence(__ATOMIC_RELEASE, "agent");
            asm volatile("s_waitcnt vmcnt(0)" ::: "memory");
            const unsigned og = xb_add(&bar[XB_TOP], 1u);
            const unsigned tg = og / nx;
            if (og + 1u == (tg + 1u) * nx) xb_add(&bar[XB_TOPGEN], 1u);
            else XB_SPIN(xb_ld(&bar[XB_TOPGEN]) == tg, bar);
            __builtin_amdgcn_fence(__ATOMIC_ACQUIRE, "agent");
            xb_add(&bar[XB_XGEN(b.x)], 1u);
            asm volatile("s_waitcnt vmcnt(0)" ::: "memory");
        } else {
            XB_SPIN(xb_ld(&bar[XB_XGEN(b.x)]) == gen, bar);
            __builtin_amdgcn_fence(__ATOMIC_ACQUIRE, "agent");
            asm volatile("s_waitcnt vmcnt(0)" ::: "memory");
        }
    }
    __syncthreads();
}

constexpr int NPHASES = 18;
__global__ void __launch_bounds__(NTHREADS, 2) mega_fwd(Args a) {
    extern __shared__ __attribute__((aligned(16))) unsigned char lds_raw[];
    LAS unsigned char* lds = (LAS unsigned char*)lds_raw;
    cg::grid_group grid = cg::this_grid();
    const int G = gridDim.x, bx = blockIdx.x;
    const int vcu = (G % 8 == 0) ? (bx % 8) * (G / 8) + bx / 8 : bx;
    unsigned char* ws = a.ws;
    bf16* const XB = (bf16*)(ws + WS_XB);
    bf16* const R0 = (bf16*)(ws + WS_R0); bf16* const R1 = (bf16*)(ws + WS_R1); bf16* const R2 = (bf16*)(ws + WS_R2);
    float* const SS = (float*)(ws + WS_SS);
    float* const KMP = (float*)(ws + WS_KMP);
    const float* const ROPE = (const float*)(ws + WS_ROPE);
    float* const X = a.out;
    volatile LAS unsigned* const MISC = (volatile LAS unsigned*)(lds + 131072);
    if (threadIdx.x < 64) MISC[threadIdx.x] = 0u;
    unsigned* const barw = (unsigned*)(ws + WS_BAR);
    if (bx == 0) for (int i = threadIdx.x; i < XCD_BAR_WORDS; i += NTHREADS) __hip_atomic_store(barw + i, 0u, __ATOMIC_RELAXED, __HIP_MEMORY_SCOPE_AGENT);
    __syncthreads();
    grid.sync();
    XcdBarrier xb = xcd_barrier_post(barw, MISC + 8);

    for (int ph = a.ph_lo; ph < a.ph_hi; ++ph) {
#ifndef PROBE_DUP_MASK
#define PROBE_DUP_MASK 0
#endif
#ifndef PROBE_EXTRA_SYNCS
#define PROBE_EXTRA_SYNCS 0
#endif
        const int nrep = ((PROBE_DUP_MASK >> ph) & 1) ? 2 : 1;
        for (int rep = 0; rep < nrep; ++rep) {
        int tid = threadIdx.x; asm volatile("" : "+v"(tid));
        int kind = 0; pg8::Gemm g{nullptr, nullptr, 0, 0, 0}; int sG = G, sc = bx;
        pg8::EpiBf16X e1{nullptr, 0, 0, 0, nullptr, nullptr, 0u, nullptr};
        pg8::EpiSwiGLU e3{nullptr, DFF, SS};
        pg8::EpiRes e4{XB, XB, SS};
        const int l = (ph >= 10) ? 1 : 0;
        switch (ph) {
        case 0:
#ifndef NO_PRO
            prologue(a, (LAS char*)lds, G, vcu, tid);
#endif
            break;
        case 1: kind = 2; g = pg8::Gemm{XB, (const bf16*)(ws + WS_WIN), T, 3 * D, D}; break;
        case 2:
            {
                if (bx < 64) { const int ll = bx >> 5; kind = 1; g = pg8::Gemm{(const bf16*)(ws + WS_MEMN) + (size_t)ll * MEMT * D, (const bf16*)(ws + WS_MWKV) + (size_t)ll * 2 * D * D, MEMT, 2 * D, D}; sG = 32; sc = bx & 31;
                    e1.O = (bf16*)(ws + WS_KVM) + (size_t)ll * MEMT * 2 * D; e1.ldc = 2 * D; }
            }
#ifndef NO_CONV
            if (bx >= 64) conv_phase(R0, R1, (nrep == 2 && rep == 0) ? R2 : R1, (const float*)a.in[9], G - 64, bx - 64, tid);
#endif
            break;
        case 3: kind = 4; g = pg8::Gemm{R1, (const bf16*)(ws + WS_WOUT), T, D, D}; break;
        case 4: case 12: kind = 1; g = pg8::Gemm{XB, (const bf16*)(ws + WS_MWQ) + (size_t)l * D * D, T, D, D}; e1.O = R0; e1.ldc = D; e1.ss = SS; break;
        case 5: case 13:
#ifndef NO_MEM
            { asm volatile("s_waitcnt vmcnt(0)" ::: "memory"); __syncthreads();
              pg8::StaticOrder Sm; Sm.init(T, D, G, bx);
              memattn_phase((LAS char*)lds, R0, (const bf16*)(ws + WS_KVM) + (size_t)l * MEMT * 2 * D, R1, Sm, tid); }
#endif
            break;
        case 6: case 14: kind = 4; g = pg8::Gemm{R1, (const bf16*)(ws + WS_MWO) + (size_t)l * D * D, T, D, D}; break;
        case 7: case 15: kind = 3; g = pg8::Gemm{XB, (const bf16*)(ws + WS_WGU + l * WGU_BYTES), T, 2 * DFF, D}; e3.ACT = R0; break;
        case 8: case 16: kind = 4; g = pg8::Gemm{R0, (const bf16*)(ws + WS_WDN + l * WDN_BYTES), T, D, DFF};
            if (nrep == 2 && rep == 0) { e4.xb = (bf16*)(ws + WS_END); e4.ss = (float*)(ws + WS_END + 32 * MiB); }
            break;
        case 9: kind = 1; g = pg8::Gemm{XB, (const bf16*)(ws + WS_WKVQ), T, 3 * D, D}; e1.O = R0; e1.ldc = D; e1.split_cols = D; e1.split_stride = (size_t)T * D; e1.ss = SS; e1.rope = ROPE; e1.rope_mask = 5u; e1.kmp = KMP; break;
        case 10:
#ifndef NO_MOBA
            #ifdef PROBE_VARIANTS
            if (!(PROBE_VARIANTS == 6 && nrep == 2 && rep == 0))
            moba_phase((LAS char*)lds, R2, R0, R1, (nrep == 2 && rep == 0) ? (bf16*)(ws + WS_END) : R2, KMP, G, vcu, tid, (nrep == 2 && rep == 0) ? PROBE_VARIANTS : 0);
#else
            moba_phase((LAS char*)lds, R2, R0, R1, (nrep == 2 && rep == 0) ? (bf16*)(ws + WS_END) : R2, KMP, G, vcu, tid);
#endif
#endif
            break;
        case 11: kind = 4; g = pg8::Gemm{R2, (const bf16*)(ws + WS_MOWO), T, D, D}; break;
        case 17:
#ifndef NO_FIN
            final_phase(XB, (nrep == 2 && rep == 0) ? (float*)R0 : X, SS, (const float*)a.in[7], G, vcu, tid);
#endif
            break;
        default: break;
        }
        if (kind) {
            pg8::StaticOrder S; S.init(g.M, g.N, sG, sc);
#ifndef NO_G1
            if (kind == 1) pg8::gemm_phase<pg8::EpiBf16X, pg8::StaticOrder, true, true>(lds, g, S, e1, tid);
#endif
#ifndef NO_G2
            if (kind == 2) { pg8::EpiMul e2{R0, R1, SS}; pg8::gemm_phase<pg8::EpiMul, pg8::StaticOrder, true, true>(lds, g, S, e2, tid); }
#endif
#ifndef NO_G3
            if (kind == 3) pg8::gemm_phase<pg8::EpiSwiGLU, pg8::StaticOrder, true, true>(lds, g, S, e3, tid);
#endif
#ifndef NO_G4
            if (kind == 4) pg8::gemm_phase<pg8::EpiRes, pg8::StaticOrder, true, true>(lds, g, S, e4, tid);
#endif
        }
        if (rep + 1 < nrep) xcd_barrier(xb);
        }
        if (ph == 1) for (int e = 0; e < PROBE_EXTRA_SYNCS; ++e) xcd_barrier(xb);
        if (ph + 1 < a.ph_hi && ph != 4 && ph != 12) {
            xcd_barrier(xb);
        }
    }
}

#ifndef MK_ONE_LAUNCH
#define MK_ONE_LAUNCH 1
#endif
extern "C" void kernel_launch(void* const* d_in, const int* in_sizes, int n_in, void* d_out, int out_size, void* d_ws, size_t ws_size, hipStream_t stream) {
    static int grid = 0;
    if (grid == 0) {
        if (n_in != 20 || out_size != T * D || ws_size < WS_END) { fprintf(stderr, "kernel_launch: unexpected shapes (n_in %d out %d ws %zu)\n", n_in, out_size, ws_size); grid = -1; return; }
        int dev = 0, cus = 0, per_cu = 0;
        hipGetDevice(&dev); hipDeviceGetAttribute(&cus, hipDeviceAttributeMultiprocessorCount, dev);
        hipFuncSetAttribute((const void*)mega_fwd, hipFuncAttributeMaxDynamicSharedMemorySize, LDS_BYTES);
        hipOccupancyMaxActiveBlocksPerMultiprocessor(&per_cu, (const void*)mega_fwd, NTHREADS, LDS_BYTES);
        if (per_cu < 1) { fprintf(stderr, "kernel_launch: occupancy query says %d blocks per CU\n", per_cu); per_cu = 1; }
        if (per_cu > 1) per_cu = 1;
        grid = cus * per_cu;
    }
    if (grid < 0) return;
    Args a{};
    for (int i = 0; i < 20; ++i) a.in[i] = d_in[i];
    a.out = (float*)d_out; a.ws = (unsigned char*)d_ws;
#if MK_ONE_LAUNCH
    a.ph_lo = 0; a.ph_hi = NPHASES;
    void* args[] = {&a};
    hipError_t e = hipLaunchCooperativeKernel((const void*)mega_fwd, dim3(grid), dim3(NTHREADS), args, LDS_BYTES, stream);
    if (e != hipSuccess) fprintf(stderr, "cooperative launch failed: %s (grid %d)\n", hipGetErrorString(e), grid);
#else
    for (int ph = 0; ph < NPHASES; ++ph) {
        a.ph_lo = ph; a.ph_hi = ph + 1;
        hipLaunchKernelGGL(mega_fwd, dim3(grid), dim3(NTHREADS), LDS_BYTES, stream, a);
    }
#endif
}
```
